# Optimizing an MI355X kernel written in HIP

```python
import math, functools
import jax, jax.numpy as jnp
from jax import lax
import numpy as np

D_MODEL = 1024
BATCH = 8
SEQ = 8192
DEPTH = 4
DEC_BATCH = 8
DEC_SEQ = 16
PAST_LEN = 2048

CHUNK = 64
HEAD_DIM = 64
N_A_LAYERS = DEPTH // 2
N_B_LAYERS = DEPTH - N_A_LAYERS
N_HEADS_A = 16
N_KV_A = 4
WINDOW = 128
A_BACK = WINDOW // CHUNK
N_HEADS_B = 16
B_BACK = 8
B_REACH = B_BACK * CHUNK
REL_CLIP = 128
N_BUCKETS = 32
T5_MAX_DIST = 128
D_FF = 2816
CONV_W = 3
LN_EPS = 1e-5
DEEPNORM_ALPHA = (2.0 * DEPTH) ** 0.25
DEEPNORM_BETA = (8.0 * DEPTH) ** -0.25
ATTN_SCALE = HEAD_DIM ** -0.5
NEG_INF = -1e30

kernel_name = 'yoco_streaming_swa_chunkband_encoder'


def layer_norm(x, g, b):
    xf = x.astype(jnp.float32)
    mu = xf.mean(-1, keepdims=True)
    var = jnp.square(xf - mu).mean(-1, keepdims=True)
    y = (xf - mu) * lax.rsqrt(var + LN_EPS)
    return (y * g.astype(jnp.float32) + b.astype(jnp.float32)).astype(x.dtype)


def t5_bias(table, qpos, kpos):
    rel = kpos[None, :] - qpos[:, None]
    nb = N_BUCKETS // 2
    max_exact = nb // 2
    n = jnp.abs(rel)
    large = max_exact + (jnp.log(jnp.maximum(n, 1).astype(jnp.float32) / max_exact)
                         / math.log(T5_MAX_DIST / max_exact) * (nb - max_exact)).astype(jnp.int32)
    large = jnp.minimum(large, nb - 1)
    bucket = jnp.where(rel > 0, nb, 0) + jnp.where(n < max_exact, n, large)
    return jnp.transpose(table[bucket], (2, 0, 1))


def relclip_bias(table, qpos, kpos):
    d = jnp.clip(qpos[:, None] - kpos[None, :], -REL_CLIP, REL_CLIP) + REL_CLIP
    return table[:, d]


def band_attend(q, k, v, qpos, kpos, bias, sinks, n_back):
    B, Lq, H, hd = q.shape
    Lk, KV = k.shape[1], k.shape[2]
    G = H // KV
    qg = q.reshape(B, Lq, KV, G, hd)
    s = jnp.einsum('bqkgd,bskd->bkgqs', qg, k).astype(jnp.float32) * ATTN_SCALE
    s = s + bias.reshape(KV, G, Lq, Lk).astype(jnp.float32)
    qc = qpos // CHUNK
    kc = kpos // CHUNK
    valid = (kpos[None, :] >= 0) & (kc[None, :] <= qc[:, None]) & (kc[None, :] >= qc[:, None] - n_back)
    s = jnp.where(valid, s, NEG_INF)
    if sinks is None:
        p = jax.nn.softmax(s, axis=-1)
    else:
        sink = sinks.astype(jnp.float32).reshape(KV, G, 1, 1)
        m = jnp.maximum(s.max(-1, keepdims=True), sink)
        e = jnp.exp(s - m)
        p = e / (e.sum(-1, keepdims=True) + jnp.exp(sink - m))
    o = jnp.einsum('bkgqs,bskd->bqkgd', p.astype(v.dtype), v)
    return o.reshape(B, Lq, H * hd)


def attn_prompt(q, k, v, n_back, bias_fn, sinks):
    B, S, H, hd = q.shape
    n_chunks = S // CHUNK
    band = (n_back + 1) * CHUNK
    pad = n_back * CHUNK
    kp = jnp.pad(k, ((0, 0), (pad, 0), (0, 0), (0, 0)))
    vp = jnp.pad(v, ((0, 0), (pad, 0), (0, 0), (0, 0)))

    def one_chunk(ci):
        start = ci * CHUNK
        qc = lax.dynamic_slice_in_dim(q, start, CHUNK, axis=1)
        kc = lax.dynamic_slice_in_dim(kp, start, band, axis=1)
        vc = lax.dynamic_slice_in_dim(vp, start, band, axis=1)
        qpos = start + jnp.arange(CHUNK, dtype=jnp.int32)
        kpos = start - pad + jnp.arange(band, dtype=jnp.int32)
        return band_attend(qc, kc, vc, qpos, kpos, bias_fn(qpos, kpos), sinks, n_back)

    o = lax.map(one_chunk, jnp.arange(n_chunks, dtype=jnp.int32))
    return jnp.swapaxes(o, 0, 1).reshape(B, S, H * hd)


def attn_sample(q, k_new, v_new, k_cache, v_cache, n_back, bias_fn, sinks):
    B, T, H, hd = q.shape
    P = k_cache.shape[1]
    k = jnp.concatenate([k_cache.astype(k_new.dtype), k_new], axis=1)
    v = jnp.concatenate([v_cache.astype(v_new.dtype), v_new], axis=1)
    qpos = PAST_LEN + jnp.arange(T, dtype=jnp.int32)
    kpos = PAST_LEN - P + jnp.arange(P + T, dtype=jnp.int32)
    return band_attend(q, k, v, qpos, kpos, bias_fn(qpos, kpos), sinks, n_back)


def conv_ffn(h, prev, w_up, conv_w, conv_b, w_down):
    u = h @ w_up
    B, T, C = u.shape
    if prev is None:
        prev = jnp.zeros((B, CONV_W - 1, C), u.dtype)
    ue = jnp.concatenate([prev.astype(u.dtype), u], axis=1)
    y = conv_b
    for tap in range(CONV_W):
        y = y + conv_w[tap] * ue[:, tap:tap + T]
    a, g = jnp.split(y, 2, axis=-1)
    out = (jax.nn.gelu(g) * a) @ w_down
    return out, ue[:, T:]


def run_group(x, c, cache_a_k, cache_a_v, cache_b_k, cache_b_v, state_conv,
              w_ada, b_ada, ln_g, ln_b, w_qkv_a, w_o_a, sinks_a, t5_table,
              w_ada_kv, b_ada_kv, w_kv_b, w_q_b, w_o_b, relpos_b,
              w_up, conv_w, conv_b, w_down):
    prompt = cache_a_k is None
    B, T, _ = x.shape
    sc = jax.nn.silu(c)
    new_ak, new_av, new_conv = [], [], []
    k_b = v_b = None
    qa = N_HEADS_A * HEAD_DIM
    ka = N_KV_A * HEAD_DIM
    for l in range(DEPTH):
        ada = (sc @ w_ada[l] + b_ada[l])[:, None, :]
        sh_m, sc_m, g_m, sh_f, sc_f, g_f = jnp.split(ada, 6, axis=-1)
        h = x * (1 + sc_m) + sh_m
        if l < N_A_LAYERS:
            qkv = h @ w_qkv_a[l]
            q = qkv[..., :qa].reshape(B, T, N_HEADS_A, HEAD_DIM)
            k = qkv[..., qa:qa + ka].reshape(B, T, N_KV_A, HEAD_DIM)
            v = qkv[..., qa + ka:].reshape(B, T, N_KV_A, HEAD_DIM)
            bias_fn = functools.partial(t5_bias, t5_table)
            if prompt:
                o = attn_prompt(q, k, v, A_BACK, bias_fn, sinks_a[l])
                rows = min(WINDOW, T)
                new_ak.append(k[:, T - rows:])
                new_av.append(v[:, T - rows:])
            else:
                o = attn_sample(q, k, v, cache_a_k[l], cache_a_v[l], A_BACK, bias_fn, sinks_a[l])
                new_ak.append(k)
                new_av.append(v)
            mix = o @ w_o_a[l]
        else:
            j = l - N_A_LAYERS
            q = (h @ w_q_b[j]).reshape(B, T, N_HEADS_B, HEAD_DIM)
            bias_fn = functools.partial(relclip_bias, relpos_b[j])
            if prompt:
                o = attn_prompt(q, k_b, v_b, B_BACK, bias_fn, None)
            else:
                o = attn_sample(q, k_b, v_b, cache_b_k, cache_b_v, B_BACK, bias_fn, None)
            mix = o @ w_o_b[j]
        x = layer_norm(DEEPNORM_ALPHA * x + (1 + g_m) * mix, ln_g[l, 0], ln_b[l, 0])
        h = x * (1 + sc_f) + sh_f
        f, conv_rows = conv_ffn(h, None if prompt else state_conv[l], w_up[l], conv_w[l], conv_b[l], w_down[l])
        new_conv.append(conv_rows)
        x = layer_norm(DEEPNORM_ALPHA * x + (1 + g_f) * f, ln_g[l, 1], ln_b[l, 1])
        if l == N_A_LAYERS - 1:
            ada_kv = (sc @ w_ada_kv + b_ada_kv)[:, None, :]
            sh_kv, sc_kv = jnp.split(ada_kv, 2, axis=-1)
            kv = ((x * (1 + sc_kv) + sh_kv) @ w_kv_b).reshape(B, T, 2, N_HEADS_B, HEAD_DIM)
            k_b = kv[:, :, 0]
            v_b = kv[:, :, 1]
    if prompt:
        rows = min(B_REACH, T)
        b_k_rows = k_b[:, T - rows:]
        b_v_rows = v_b[:, T - rows:]
    else:
        b_k_rows = k_b
        b_v_rows = v_b
    return (x, jnp.stack(new_ak), jnp.stack(new_av), b_k_rows, b_v_rows, jnp.stack(new_conv))


def setup_inputs(seed: int = 0) -> dict:
    key = jax.random.key(seed)
    ks = jax.random.split(key, 32)
    f32 = jnp.float32

    def nrm(k, shape, s):
        return jax.random.normal(k, shape, f32) * s

    a_rows = min(WINDOW, PAST_LEN)
    b_rows = min(B_REACH, PAST_LEN)
    beta = DEEPNORM_BETA
    return {
        'x_prompt': nrm(ks[0], (BATCH, SEQ, D_MODEL), 1.0),
        'x_sample': nrm(ks[1], (DEC_BATCH, DEC_SEQ, D_MODEL), 1.0),
        'c_prompt': nrm(ks[2], (BATCH, D_MODEL), 1.0),
        'c_sample': nrm(ks[3], (DEC_BATCH, D_MODEL), 1.0),
        'cache_a_k': nrm(ks[4], (N_A_LAYERS, DEC_BATCH, a_rows, N_KV_A, HEAD_DIM), 1.0),
        'cache_a_v': nrm(ks[5], (N_A_LAYERS, DEC_BATCH, a_rows, N_KV_A, HEAD_DIM), 1.0),
        'cache_b_k': nrm(ks[6], (DEC_BATCH, b_rows, N_HEADS_B, HEAD_DIM), 1.0),
        'cache_b_v': nrm(ks[7], (DEC_BATCH, b_rows, N_HEADS_B, HEAD_DIM), 1.0),
        'state_conv': nrm(ks[8], (DEPTH, DEC_BATCH, CONV_W - 1, 2 * D_FF), 1.0),
        'w_ada': nrm(ks[9], (DEPTH, D_MODEL, 6 * D_MODEL), 0.1 * D_MODEL ** -0.5),
        'b_ada': nrm(ks[10], (DEPTH, 6 * D_MODEL), 0.02),
        'ln_g': 1.0 + nrm(ks[11], (DEPTH, 2, D_MODEL), 0.02),
        'ln_b': nrm(ks[12], (DEPTH, 2, D_MODEL), 0.02),
        'w_qkv_a': nrm(ks[13], (N_A_LAYERS, D_MODEL, (N_HEADS_A + 2 * N_KV_A) * HEAD_DIM), D_MODEL ** -0.5),
        'w_o_a': nrm(ks[14], (N_A_LAYERS, N_HEADS_A * HEAD_DIM, D_MODEL), beta * (N_HEADS_A * HEAD_DIM) ** -0.5),
        'sinks_a': nrm(ks[15], (N_A_LAYERS, N_HEADS_A), 0.5),
        't5_table': nrm(ks[16], (N_BUCKETS, N_HEADS_A), 0.5),
        'w_ada_kv': nrm(ks[17], (D_MODEL, 2 * D_MODEL), 0.1 * D_MODEL ** -0.5),
        'b_ada_kv': nrm(ks[18], (2 * D_MODEL,), 0.02),
        'w_kv_b': nrm(ks[19], (D_MODEL, 2 * N_HEADS_B * HEAD_DIM), D_MODEL ** -0.5),
        'w_q_b': nrm(ks[20], (N_B_LAYERS, D_MODEL, N_HEADS_B * HEAD_DIM), D_MODEL ** -0.5),
        'w_o_b': nrm(ks[21], (N_B_LAYERS, N_HEADS_B * HEAD_DIM, D_MODEL), beta * (N_HEADS_B * HEAD_DIM) ** -0.5),
        'relpos_b': nrm(ks[22], (N_B_LAYERS, N_HEADS_B, 2 * REL_CLIP + 1), 0.5),
        'w_up': nrm(ks[23], (DEPTH, D_MODEL, 2 * D_FF), D_MODEL ** -0.5),
        'conv_w': nrm(ks[24], (DEPTH, CONV_W, 2 * D_FF), CONV_W ** -0.5),
        'conv_b': nrm(ks[25], (DEPTH, 2 * D_FF), 0.02),
        'w_down': nrm(ks[26], (DEPTH, D_FF, D_MODEL), beta * D_FF ** -0.5),
    }


def reference(x_prompt, x_sample, c_prompt, c_sample, cache_a_k, cache_a_v, cache_b_k, cache_b_v,
              state_conv, w_ada, b_ada, ln_g, ln_b, w_qkv_a, w_o_a, sinks_a, t5_table,
              w_ada_kv, b_ada_kv, w_kv_b, w_q_b, w_o_b, relpos_b, w_up, conv_w, conv_b, w_down):
    weights = (w_ada, b_ada, ln_g, ln_b, w_qkv_a, w_o_a, sinks_a, t5_table,
               w_ada_kv, b_ada_kv, w_kv_b, w_q_b, w_o_b, relpos_b, w_up, conv_w, conv_b, w_down)
    y_prompt, p_ak, p_av, p_bk, p_bv, p_conv = run_group(
        x_prompt, c_prompt, None, None, None, None, None, *weights)
    y_sample, s_ak, s_av, s_bk, s_bv, s_conv = run_group(
        x_sample, c_sample, cache_a_k, cache_a_v, cache_b_k, cache_b_v, state_conv, *weights)
    return (y_prompt, y_sample, p_ak, p_av, p_bk, p_bv, p_conv, s_ak, s_av, s_bk, s_bv, s_conv)
```

```cpp
#include <hip/hip_runtime.h>
#include <hip/hip_cooperative_groups.h>
#include <cstdio>
#include <cstdint>
namespace cg = cooperative_groups;

#define LAS __attribute__((address_space(3)))
typedef unsigned short bf16_t;
typedef short bf16x8 __attribute__((ext_vector_type(8)));
typedef float f32x4 __attribute__((ext_vector_type(4)));
typedef unsigned u32x4 __attribute__((ext_vector_type(4)));
typedef unsigned u32x2 __attribute__((ext_vector_type(2)));

constexpr int DM = 1024, SEQ = 8192, NBATCH = 8, MP = NBATCH * SEQ, MS = 128, MREAL = MP + MS, MR = 65792;
constexpr int FF = 2816, FF2 = 5632;
constexpr float ALPHA = 1.681792830507429f;
constexpr float LN_EPS = 1e-5f;
constexpr float LOG2E = 1.4426950408889634f;
constexpr float SCALE2 = 0.125f * LOG2E;

constexpr size_t O_Y = 0;
constexpr size_t O_AKP = (size_t)MREAL * DM;
constexpr size_t O_AVP = O_AKP + 2 * 8 * 128 * 256;
constexpr size_t O_BKP = O_AVP + 2 * 8 * 128 * 256;
constexpr size_t O_BVP = O_BKP + (size_t)8 * 512 * 1024;
constexpr size_t O_CVP = O_BVP + (size_t)8 * 512 * 1024;
constexpr size_t O_AKS = O_CVP + 4 * 8 * 2 * FF2;
constexpr size_t O_AVS = O_AKS + 2 * 128 * 256;
constexpr size_t O_BKS = O_AVS + 2 * 128 * 256;
constexpr size_t O_BVS = O_BKS + 128 * 1024;
constexpr size_t O_CVS = O_BVS + 128 * 1024;
constexpr size_t O_END = O_CVS + 4 * 8 * 2 * FF2;

constexpr size_t MiB = 1u << 20;
constexpr size_t WS_WQKV = 1 * MiB, WS_WOA = 7 * MiB, WS_WKV = 11 * MiB, WS_WQB = 15 * MiB, WS_WOB = 19 * MiB, WS_WUP = 23 * MiB, WS_WDN = 67 * MiB;
constexpr size_t WS_ADA = 89 * MiB, WS_ADAKV = 90 * MiB + 512 * 1024, WS_USAMP = 91 * MiB, WS_UH = 94 * MiB;
constexpr size_t WS_H = 183 * MiB, WS_KVB = 312 * MiB, WS_R = 569 * MiB;
constexpr size_t WS_QKV = WS_R, WS_O = WS_R + 193 * MiB, WS_HKV = WS_R + 224 * MiB, WS_ACT = WS_R, WS_END = 923 * MiB;
static_assert(WS_UH + (size_t)1024 * 4 * FF2 * 4 <= WS_H, "uh");
static_assert(WS_H + (size_t)MR * DM * 2 <= WS_KVB, "h");
static_assert(WS_KVB + (size_t)MR * 2048 * 2 <= WS_R, "kvb");
static_assert(WS_ACT + (size_t)MR * FF * 2 <= WS_END && WS_HKV + (size_t)MR * DM * 2 <= WS_END && WS_QKV + (size_t)MR * 1536 * 2 <= WS_O && WS_O + (size_t)MR * DM * 2 <= WS_END, "r");

constexpr int LDS_BYTES = 147456;

struct Params { const float* in[27]; float* out; unsigned char* ws; };

__device__ __forceinline__ int opaque_tid() { int t = threadIdx.x; asm volatile("" : "+v"(t)); return t; }
__device__ __forceinline__ unsigned cvt_pk_bf16(float lo, float hi) { unsigned r; asm volatile("v_cvt_pk_bf16_f32 %0, %1, %2" : "=v"(r) : "v"(lo), "v"(hi)); return r; }
__device__ __forceinline__ float bf2f(unsigned short h) { return __builtin_bit_cast(float, (unsigned)h << 16); }
__device__ __forceinline__ int ada_row(int row) { int r = row < MP ? (row >> 13) : 8 + ((row - MP) >> 4); return r > 15 ? 15 : r; }
__device__ __forceinline__ float gelu_tanh(float x) {
    const float z = 0.7978845608028654f * (x + 0.044715f * x * x * x);
    const float t = __builtin_amdgcn_exp2f(z * (2.0f * LOG2E));
    return x - x * __builtin_amdgcn_rcpf(1.0f + t);
}
__device__ __forceinline__ float wave_sum(float v) {
#pragma unroll
    for (int o = 1; o < 64; o <<= 1) v += __shfl_xor(v, o);
    return v;
}
__device__ __forceinline__ float wave_max(float v) {
#pragma unroll
    for (int o = 1; o < 64; o <<= 1) v = fmaxf(v, __shfl_xor(v, o));
    return v;
}

namespace pg8 {
constexpr int BM = 256, BK = 64, HALF = 128, HTB = HALF * BK * 2, STAGE_BYTES = 8 * HTB, NXCD = 8, WGM = 8;
__host__ __device__ __forceinline__ int lds_byte(int r, int c) { const int st = (r >> 4) * 2 + (c >> 5), rr = r & 15, cc = c & 31, ob = rr * 64 + cc * 2; return st * 1024 + (ob ^ (((ob >> 9) & 1) << 5)); }
__host__ __device__ __forceinline__ void stage_rc(int b, int& R, int& C) { const int st = b / 1024, sb = b % 1024, swz = sb ^ (((sb >> 9) & 1) << 5); R = (st >> 1) * 16 + swz / 64; C = (st & 1) * 32 + (swz % 64) / 2; }
__host__ __device__ __forceinline__ int perm32(int rho) { const int n = rho >> 4, i = rho & 15; return 8 * (i >> 2) + 4 * n + (i & 3); }

struct Unit { int pm, pn; };
struct Gemm { const bf16_t* A; const bf16_t* Bt; int M, N, K; };

struct StaticOrder {
    int nM, nN, nwg, G, c;
    __device__ void init(int M, int N, int G_, int c_) { nM = M / BM; nN = N / BM; nwg = nM * nN; G = G_; c = c_; }
    __device__ bool next(int i, Unit& u) const {
        const long L = (long)i * G + c; if (L >= nwg) return false;
        int wgid = (int)L; { const int q = nwg / NXCD, r = nwg % NXCD, xcd = wgid % NXCD, off = wgid / NXCD; wgid = (xcd < r ? xcd * (q + 1) : r * (q + 1) + (xcd - r) * q) + off; }
        const int nig = WGM * nN, gid = wgid / nig, fm = gid * WGM, gsz = (nM - fm) < WGM ? (nM - fm) : WGM;
        u.pm = fm + ((wgid % nig) % gsz); u.pn = (wgid % nig) / gsz; return true;
    }
};

template <class Epi, class Sched>
__device__ __forceinline__ void gemm_phase(LAS unsigned char* lds, const Gemm g, const Sched& S, const Epi& E) {
    const int tid = opaque_tid(), wid = __builtin_amdgcn_readfirstlane(tid >> 6), lane = tid & 63, wr = wid >> 2, wc = wid & 3, fr = lane & 15, fq = lane >> 4;
    const int K = g.K, nt = K / BK;
    unsigned voffA[2], voffB[2];
#pragma unroll
    for (int i = 0; i < 2; ++i) { int R, C; stage_rc(tid * 16 + i * 8192, R, C); const int Rb = Epi::PERM ? ((R & ~31) + perm32(R & 31)) : R;
        const int Ra = Epi::ROWPERM ? ((R & 64) | ((R & 15) << 2) | ((R >> 4) & 3)) : R;
        voffA[i] = (unsigned)(Ra * K + C) * 2u; voffB[i] = (unsigned)(Rb * K + C) * 2u; }
    const size_t kstep = (size_t)(BK * 2);
    const size_t hstep = (size_t)HALF * K * 2;
    const size_t tstep = 2 * hstep;
    const unsigned ldsw = (unsigned)wid * 1024u;
    const int aoff = lds_byte(wr * 64 + fr, fq * 8), boff = lds_byte(wc * 32 + fr, fq * 8);
#define PG8_SA(b, h) (((b) * 2 + (h)) * HTB)
#define PG8_SB(b, h) ((4 + (b) * 2 + (h)) * HTB)
#define PG8_STAGE(bufoff, gbase, voff) do { _Pragma("unroll") for (int _i = 0; _i < 2; ++_i) \
        __builtin_amdgcn_global_load_lds((const unsigned*)((const char*)(gbase) + (voff)[_i]), (LAS unsigned*)(lds + (bufoff) + ldsw + _i * 8192), 16, 0, 0); } while (0)
#define PG8_LDA(dst, b, h) do { _Pragma("unroll") for (int m = 0; m < 4; ++m) _Pragma("unroll") for (int k = 0; k < 2; ++k) dst[m][k] = *(const LAS bf16x8*)(lds + PG8_SA(b, h) + aoff + m * 2048 + k * 1024); } while (0)
#define PG8_LDB(dst, b, h) do { _Pragma("unroll") for (int n = 0; n < 2; ++n) _Pragma("unroll") for (int k = 0; k < 2; ++k) dst[n][k] = *(const LAS bf16x8*)(lds + PG8_SB(b, h) + boff + n * 2048 + k * 1024); } while (0)
#define PG8_MMA(ai, bj, At, Bt) do { __builtin_amdgcn_s_setprio(1); _Pragma("unroll") for (int m = 0; m < 4; ++m) _Pragma("unroll") for (int n = 0; n < 2; ++n) _Pragma("unroll") for (int k = 0; k < 2; ++k) \
        acc[ai][bj][m][n] = __builtin_amdgcn_mfma_f32_16x16x32_bf16(Bt[n][k], At[m][k], acc[ai][bj][m][n], 0, 0, 0); __builtin_amdgcn_s_setprio(0); } while (0)
#define PG8_WAIT_V(n) asm volatile("s_waitcnt vmcnt(" #n ")" ::: "memory")
#define PG8_WAIT_L(n) asm volatile("s_waitcnt lgkmcnt(" #n ")" ::: "memory")
#define PG8_BAR __builtin_amdgcn_s_barrier()
#define PG8_SCHED __builtin_amdgcn_sched_barrier(0)
    Unit cur, nxt; int ui = 0;
    if (!S.next(0, cur)) return;
    f32x4 acc[2][2][4][2];
#pragma unroll
    for (int a = 0; a < 2; ++a)
#pragma unroll
        for (int b = 0; b < 2; ++b)
#pragma unroll
            for (int m = 0; m < 4; ++m)
#pragma unroll
                for (int n = 0; n < 2; ++n) acc[a][b][m][n] = (f32x4){0.f, 0.f, 0.f, 0.f};
    bf16x8 At[4][2], B0[2][2], B1[2][2];
    const char* cA = (const char*)g.A + (size_t)cur.pm * tstep; const char* cB = (const char*)g.Bt + (size_t)cur.pn * tstep;
    PG8_STAGE(PG8_SB(0, 0), cB, voffB); PG8_STAGE(PG8_SB(0, 1), cB + hstep, voffB); PG8_STAGE(PG8_SA(0, 0), cA, voffA); PG8_STAGE(PG8_SA(0, 1), cA + hstep, voffA);
    if (wr == 1) PG8_BAR;
    PG8_WAIT_V(2); PG8_BAR;
    PG8_STAGE(PG8_SB(1, 0), cB + kstep, voffB); PG8_STAGE(PG8_SA(1, 0), cA + kstep, voffA); PG8_STAGE(PG8_SB(1, 1), cB + hstep + kstep, voffB);
    PG8_WAIT_V(6); PG8_BAR;
    for (;;) {
        const bool has_next = S.next(ui + 1, nxt);
        const char* nA = has_next ? (const char*)g.A + (size_t)nxt.pm * tstep : cA; const char* nB = has_next ? (const char*)g.Bt + (size_t)nxt.pn * tstep : cB;
        for (int t = 0; t < nt; t += 2) {
            const bool last = (t == nt - 2);
            const char* a1 = cA + (size_t)(t + 1) * kstep;
            const char* a2 = last ? nA : cA + (size_t)(t + 2) * kstep; const char* b2 = last ? nB : cB + (size_t)(t + 2) * kstep;
            const char* a3 = a2 + kstep; const char* b3 = b2 + kstep;
            PG8_LDB(B0, 0, 0); PG8_LDB(B1, 0, 1); PG8_SCHED; PG8_LDA(At, 0, 0); PG8_STAGE(PG8_SA(1, 1), a1 + hstep, voffA);
            PG8_WAIT_V(8); PG8_WAIT_L(0); PG8_BAR; PG8_MMA(0, 0, At, B0); PG8_MMA(0, 1, At, B1); PG8_BAR; PG8_SCHED;
            PG8_LDA(At, 0, 1); PG8_STAGE(PG8_SB(0, 0), b2, voffB); PG8_STAGE(PG8_SB(0, 1), b2 + hstep, voffB); PG8_STAGE(PG8_SA(0, 0), a2, voffA);
            PG8_WAIT_V(8); PG8_WAIT_L(0); PG8_BAR; PG8_MMA(1, 0, At, B0); PG8_MMA(1, 1, At, B1); PG8_BAR; PG8_SCHED;
            PG8_LDB(B0, 1, 0); PG8_LDB(B1, 1, 1); PG8_SCHED; PG8_LDA(At, 1, 0); PG8_STAGE(PG8_SA(0, 1), a2 + hstep, voffA);
            PG8_WAIT_V(8); PG8_WAIT_L(0); PG8_BAR; PG8_MMA(0, 0, At, B0); PG8_MMA(0, 1, At, B1); PG8_BAR; PG8_SCHED;
            PG8_LDA(At, 1, 1); PG8_STAGE(PG8_SB(1, 0), b3, voffB); PG8_STAGE(PG8_SB(1, 1), b3 + hstep, voffB); PG8_STAGE(PG8_SA(1, 0), a3, voffA);
            PG8_WAIT_V(8); PG8_WAIT_L(0); PG8_BAR; PG8_MMA(1, 0, At, B0); PG8_MMA(1, 1, At, B1); PG8_BAR; PG8_SCHED;
        }
        if (wr == 0) PG8_BAR;
        E(acc, cur, wr, wc, fr, fq);
        if (!has_next) break;
#pragma unroll
        for (int a = 0; a < 2; ++a)
#pragma unroll
            for (int b = 0; b < 2; ++b)
#pragma unroll
                for (int m = 0; m < 4; ++m)
#pragma unroll
                    for (int n = 0; n < 2; ++n) acc[a][b][m][n] = (f32x4){0.f, 0.f, 0.f, 0.f};
        cur = nxt; cA = nA; cB = nB; ++ui;
        if (wr == 1) PG8_BAR;
    }
    PG8_WAIT_V(0);
    PG8_BAR;
#undef PG8_SA
#undef PG8_SB
#undef PG8_STAGE
#undef PG8_LDA
#undef PG8_LDB
#undef PG8_MMA
#undef PG8_WAIT_V
#undef PG8_WAIT_L
#undef PG8_BAR
#undef PG8_SCHED
}
}

struct Extra { float* pp; float* ps; int c0, width, keep; };

struct EpiProj {
    static constexpr bool PERM = true, ROWPERM = false;
    bf16_t* O; int ldc; Extra e0, e1;
    __device__ __forceinline__ void operator()(const f32x4 (&acc)[2][2][4][2], const pg8::Unit& u, int wr, int wc, int fr, int fq) const {
        const int colt = u.pn * 256;
        const int col0 = colt + wc * 32 + 8 * fq;
        float* xp = nullptr; float* xs = nullptr; int xc0 = 0, xw = 0, xkeep = 0;
        if (e0.width && colt >= e0.c0 && colt < e0.c0 + e0.width) { xp = e0.pp; xs = e0.ps; xc0 = e0.c0; xw = e0.width; xkeep = e0.keep; }
        else if (e1.width && colt >= e1.c0 && colt < e1.c0 + e1.width) { xp = e1.pp; xs = e1.ps; xc0 = e1.c0; xw = e1.width; xkeep = e1.keep; }
#pragma unroll
        for (int ai = 0; ai < 2; ++ai) {
            if (u.pm == 256 && ai == 1) continue;
#pragma unroll
            for (int m = 0; m < 4; ++m) {
                const int row = u.pm * 256 + ai * 128 + wr * 64 + m * 16 + fr;
                bf16_t* rowp = O + (size_t)row * ldc + col0;
#pragma unroll
                for (int bj = 0; bj < 2; ++bj) {
                    const f32x4 v0 = acc[ai][bj][m][0], v1 = acc[ai][bj][m][1];
                    u32x4 w; w.x = cvt_pk_bf16(v0[0], v0[1]); w.y = cvt_pk_bf16(v0[2], v0[3]); w.z = cvt_pk_bf16(v1[0], v1[1]); w.w = cvt_pk_bf16(v1[2], v1[3]);
                    *(u32x4*)(rowp + bj * 128) = w;
                }
                if (xw) {
                    float* d = nullptr;
                    if (row < MP) { const int t = row & (SEQ - 1), b = row >> 13; if (t >= SEQ - xkeep) d = xp + (size_t)(b * xkeep + t - (SEQ - xkeep)) * xw; }
                    else d = xs + (size_t)(row - MP) * xw;
                    if (d) { d += col0 - xc0;
#pragma unroll
                        for (int bj = 0; bj < 2; ++bj) { *(f32x4*)(d + bj * 128) = acc[ai][bj][m][0]; *(f32x4*)(d + bj * 128 + 4) = acc[ai][bj][m][1]; } }
                }
            }
        }
    }
};

struct EpiRes {
    static constexpr bool PERM = false, ROWPERM = false;
    const float* xp; const float* xs; float* out; const float* gate;
    __device__ __forceinline__ void operator()(const f32x4 (&acc)[2][2][4][2], const pg8::Unit& u, int wr, int wc, int fr, int fq) const {
        const int col0 = u.pn * 256 + wc * 32 + 4 * fq;
#pragma unroll
        for (int ai = 0; ai < 2; ++ai) {
            if (u.pm == 256 && ai == 1) continue;
#pragma unroll
            for (int m = 0; m < 4; ++m) {
                const int row = u.pm * 256 + ai * 128 + wr * 64 + m * 16 + fr;
                const float* xr = (row < MP ? xp + (size_t)row * DM : xs + (size_t)(row - MP) * DM) + col0;
                const float* gr = gate + ada_row(row) * 6144 + col0;
                float* orow = out + (size_t)row * DM + col0;
#pragma unroll
                for (int bj = 0; bj < 2; ++bj)
#pragma unroll
                    for (int n = 0; n < 2; ++n) {
                        const int c = bj * 128 + n * 16;
                        const f32x4 xv = *(const f32x4*)(xr + c), gv = *(const f32x4*)(gr + c);
                        *(f32x4*)(orow + c) = xv * ALPHA + (gv + 1.0f) * acc[ai][bj][m][n];
                    }
            }
        }
    }
};

struct EpiUp {
    static constexpr bool PERM = true, ROWPERM = true;
    bf16_t* ACT; float* UH; float* USAMP; const float* cw; const float* cb; float* convp;
    __device__ __forceinline__ void operator()(const f32x4 (&acc)[2][2][4][2], const pg8::Unit& u, int wr, int wc, int fr, int fq) const {
        const int ca0 = u.pn * 128 + wc * 32 + 8 * fq;
        if (u.pm == 256) {
#pragma unroll
            for (int m = 0; m < 4; ++m) { float* d = USAMP + (size_t)(wr * 64 + 4 * fr + m) * FF2 + ca0;
#pragma unroll
                for (int bj = 0; bj < 2; ++bj) { *(f32x4*)(d + bj * FF) = acc[0][bj][m][0]; *(f32x4*)(d + bj * FF + 4) = acc[0][bj][m][1]; } }
            return;
        }
#pragma unroll
        for (int n = 0; n < 2; ++n) {
            const int ca = ca0 + 4 * n;
            f32x4 w0[2], w1[2], w2[2], bb[2];
#pragma unroll
            for (int bj = 0; bj < 2; ++bj) { const int c = bj * FF + ca; w0[bj] = *(const f32x4*)(cw + c); w1[bj] = *(const f32x4*)(cw + FF2 + c); w2[bj] = *(const f32x4*)(cw + 2 * FF2 + c); bb[bj] = *(const f32x4*)(cb + c); }
#pragma unroll
            for (int ai = 0; ai < 2; ++ai) {
                f32x4 p2[2], p3[2];
#pragma unroll
                for (int bj = 0; bj < 2; ++bj)
#pragma unroll
                    for (int j = 0; j < 4; ++j) { p2[bj][j] = __shfl_up(acc[ai][bj][2][n][j], 1, 16); p3[bj][j] = __shfl_up(acc[ai][bj][3][n][j], 1, 16); }
                const int grp = u.pm * 4 + ai * 2 + wr;
                const int row0 = grp * 64 + 4 * fr;
#pragma unroll
                for (int m = 0; m < 4; ++m) {
                    const bool halo = (fr == 0 && m < 2) || (fr == 15 && m >= 2);
                    if (halo) { float* d = UH + ((size_t)(grp * 4 + m)) * FF2 + ca;
                        *(f32x4*)(d) = acc[ai][0][m][n]; *(f32x4*)(d + FF) = acc[ai][1][m][n]; }
                    if (fr == 15 && m >= 2 && ai == 1 && wr == 1 && (u.pm & 31) == 31) { float* d = convp + (size_t)((u.pm >> 5) * 2 + (m - 2)) * FF2 + ca;
                        *(f32x4*)(d) = acc[ai][0][m][n]; *(f32x4*)(d + FF) = acc[ai][1][m][n]; }
                    if (fr == 0 && m < 2) continue;
                    f32x4 y[2];
#pragma unroll
                    for (int bj = 0; bj < 2; ++bj) {
                        const f32x4 u0 = acc[ai][bj][m][n];
                        const f32x4 u1 = (m >= 1) ? acc[ai][bj][m >= 1 ? m - 1 : 0][n] : p3[bj];
                        const f32x4 u2 = (m >= 2) ? acc[ai][bj][m >= 2 ? m - 2 : 0][n] : (m == 1 ? p3[bj] : p2[bj]);
                        y[bj] = bb[bj] + w2[bj] * u0 + w1[bj] * u1 + w0[bj] * u2;
                    }
                    float a0 = gelu_tanh(y[1][0]) * y[0][0], a1 = gelu_tanh(y[1][1]) * y[0][1], a2 = gelu_tanh(y[1][2]) * y[0][2], a3 = gelu_tanh(y[1][3]) * y[0][3];
                    u32x2 w; w.x = cvt_pk_bf16(a0, a1); w.y = cvt_pk_bf16(a2, a3);
                    *(u32x2*)(ACT + (size_t)(row0 + m) * FF + ca) = w;
                }
            }
        }
    }
};

__device__ __forceinline__ void p0_ada(unsigned char* lds, const Params& P) {
    const int tid = opaque_tid(), lane = tid & 63, w = __builtin_amdgcn_readfirstlane(tid >> 6);
    float* scT = (float*)lds;
    float* red = scT + 16384;
    const float* cp = P.in[2]; const float* cs = P.in[3];
    for (int idx = tid; idx < 16384; idx += 512) { const int r = idx >> 10, k = idx & 1023; const float c = r < 8 ? cp[r * 1024 + k] : cs[(r - 8) * 1024 + k]; scT[k * 16 + r] = c / (1.0f + __expf(-c)); }
    __syncthreads();
    float* ada = (float*)(P.ws + WS_ADA); float* adakv = (float*)(P.ws + WS_ADAKV);
    for (int item = blockIdx.x; item < 416; item += gridDim.x) {
        { const int gc = item * 64 + lane; const float* W; int ldw;
          if (gc < 24576) { const int l = gc / 6144, n = gc - l * 6144; W = P.in[9] + (size_t)l * 1024 * 6144 + n; ldw = 6144; }
          else { W = P.in[17] + (gc - 24576); ldw = 2048; }
          float acc[16];
#pragma unroll
          for (int r = 0; r < 16; ++r) acc[r] = 0.f;
#pragma unroll 8
          for (int kk = 0; kk < 128; ++kk) { const int k = w * 128 + kk; const float wv = W[(size_t)k * ldw];
              const f32x4 s0 = *(const f32x4*)(scT + k * 16), s1 = *(const f32x4*)(scT + k * 16 + 4), s2 = *(const f32x4*)(scT + k * 16 + 8), s3 = *(const f32x4*)(scT + k * 16 + 12);
#pragma unroll
              for (int j = 0; j < 4; ++j) { acc[j] += s0[j] * wv; acc[4 + j] += s1[j] * wv; acc[8 + j] += s2[j] * wv; acc[12 + j] += s3[j] * wv; } }
#pragma unroll
          for (int r = 0; r < 16; ++r) red[(w * 16 + r) * 64 + lane] = acc[r]; }
        __syncthreads();
        for (int idx = tid; idx < 1024; idx += 512) { const int r = idx >> 6, cl = idx & 63; float s = 0.f;
#pragma unroll
            for (int ww = 0; ww < 8; ++ww) s += red[(ww * 16 + r) * 64 + cl];
            const int gc = item * 64 + cl;
            if (gc < 24576) { const int l = gc / 6144, n = gc - l * 6144; ada[(size_t)(l * 16 + r) * 6144 + n] = s + P.in[10][l * 6144 + n]; }
            else { const int n = gc - 24576; adakv[r * 2048 + n] = s + P.in[18][n]; } }
        __syncthreads();
    }
}

__device__ __forceinline__ int upmap(int n) { return n < FF ? (n >> 7) * 256 + (n & 127) : ((n - FF) >> 7) * 256 + 128 + ((n - FF) & 127); }

__device__ __forceinline__ void p0_transpose_item(const float* W, int K, int N, bf16_t* WT, int up, float* scr, int item, int lane) {
    const int nblk = N / 32, kb = item / nblk, nb = item % nblk, k0 = 64 * kb, n0 = 32 * nb;
    const int d0 = up ? upmap(n0) : n0;
#pragma unroll 8
    for (int i = 0; i < 32; ++i) { const int kk = 2 * i + (lane >> 5); scr[kk * 33 + (lane & 31)] = W[(size_t)(k0 + kk) * N + n0 + (lane & 31)]; }
    asm volatile("s_waitcnt lgkmcnt(0)" ::: "memory");
    const int c = lane & 7;
#pragma unroll
    for (int j = 0; j < 4; ++j) { const int n = (lane >> 3) + 8 * j; const float* s = scr + (8 * c) * 33 + n;
        u32x4 o; o.x = cvt_pk_bf16(s[0 * 33], s[1 * 33]); o.y = cvt_pk_bf16(s[2 * 33], s[3 * 33]); o.z = cvt_pk_bf16(s[4 * 33], s[5 * 33]); o.w = cvt_pk_bf16(s[6 * 33], s[7 * 33]);
        *(u32x4*)(WT + (size_t)(d0 + n) * K + k0 + 8 * c) = o; }
    asm volatile("s_waitcnt lgkmcnt(0)" ::: "memory");
}

__device__ __forceinline__ void p0_weights(unsigned char* lds, const Params& P) {
    const int tid = opaque_tid(), lane = tid & 63, w = __builtin_amdgcn_readfirstlane(tid >> 6);
    float* scr = (float*)(lds + w * 16384);
    const int gw = blockIdx.x * 8 + w, NGW = gridDim.x * 8;
    unsigned char* ws = P.ws;
    for (int it = gw; it < 22528; it += NGW) {
        int r = it;
        if (r < 1536) { const int l = r / 768; r -= l * 768; p0_transpose_item(P.in[13] + (size_t)l * 1024 * 1536, 1024, 1536, (bf16_t*)(ws + WS_WQKV) + (size_t)l * 1536 * 1024, 0, scr, r, lane); continue; } r -= 1536;
        if (r < 1024) { const int l = r / 512; r -= l * 512; p0_transpose_item(P.in[14] + (size_t)l * 1024 * 1024, 1024, 1024, (bf16_t*)(ws + WS_WOA) + (size_t)l * 1024 * 1024, 0, scr, r, lane); continue; } r -= 1024;
        if (r < 1024) { p0_transpose_item(P.in[19], 1024, 2048, (bf16_t*)(ws + WS_WKV), 0, scr, r, lane); continue; } r -= 1024;
        if (r < 1024) { const int l = r / 512; r -= l * 512; p0_transpose_item(P.in[20] + (size_t)l * 1024 * 1024, 1024, 1024, (bf16_t*)(ws + WS_WQB) + (size_t)l * 1024 * 1024, 0, scr, r, lane); continue; } r -= 1024;
        if (r < 1024) { const int l = r / 512; r -= l * 512; p0_transpose_item(P.in[21] + (size_t)l * 1024 * 1024, 1024, 1024, (bf16_t*)(ws + WS_WOB) + (size_t)l * 1024 * 1024, 0, scr, r, lane); continue; } r -= 1024;
        if (r < 11264) { const int l = r / 2816; r -= l * 2816; p0_transpose_item(P.in[23] + (size_t)l * 1024 * FF2, 1024, FF2, (bf16_t*)(ws + WS_WUP) + (size_t)l * FF2 * 1024, 1, scr, r, lane); continue; } r -= 11264;
        { const int l = r / 1408; r -= l * 1408; p0_transpose_item(P.in[26] + (size_t)l * FF * 1024, FF, 1024, (bf16_t*)(ws + WS_WDN) + (size_t)l * 1024 * FF, 0, scr, r, lane); }
    }
}

__device__ __forceinline__ void row_pass(const float* srcp, const float* srcs, bool do_ln, const float* lg, const float* lb, float* xout,
                                         const float* ada_l, int sh_chunk, int sc_chunk, bf16_t* H, const float* adakv, bf16_t* H2) {
    const int tid = opaque_tid(), lane = tid & 63, w = __builtin_amdgcn_readfirstlane(tid >> 6);
    const int gw = blockIdx.x * 8 + w, NGW = gridDim.x * 8;
    for (int row = gw; row < MREAL; row += NGW) {
        const float* xr = (row < MP ? srcp + (size_t)row * DM : srcs + (size_t)(row - MP) * DM) + 4 * lane;
        f32x4 v[4];
#pragma unroll
        for (int j = 0; j < 4; ++j) v[j] = *(const f32x4*)(xr + 256 * j);
        if (do_ln) {
            float s = 0.f;
#pragma unroll
            for (int j = 0; j < 4; ++j) s += (v[j][0] + v[j][1]) + (v[j][2] + v[j][3]);
            const float mean = wave_sum(s) * (1.f / DM); float s2 = 0.f;
#pragma unroll
            for (int j = 0; j < 4; ++j) { v[j] = v[j] - mean; s2 += (v[j][0] * v[j][0] + v[j][1] * v[j][1]) + (v[j][2] * v[j][2] + v[j][3] * v[j][3]); }
            const float rstd = 1.f / sqrtf(wave_sum(s2) * (1.f / DM) + LN_EPS);
#pragma unroll
            for (int j = 0; j < 4; ++j) { const f32x4 gg = *(const f32x4*)(lg + 4 * lane + 256 * j), bb = *(const f32x4*)(lb + 4 * lane + 256 * j); v[j] = v[j] * rstd * gg + bb; }
        }
        if (xout) {
            float* xo = xout + (size_t)row * DM + 4 * lane;
#pragma unroll
            for (int j = 0; j < 4; ++j) *(f32x4*)(xo + 256 * j) = v[j];
        }
        const int ar = ada_row(row);
        if (H) {
            const float* shp = ada_l + (size_t)ar * 6144 + sh_chunk * 1024 + 4 * lane; const float* scp = ada_l + (size_t)ar * 6144 + sc_chunk * 1024 + 4 * lane;
            bf16_t* ho = H + (size_t)row * DM + 4 * lane;
#pragma unroll
            for (int j = 0; j < 4; ++j) { const f32x4 sh = *(const f32x4*)(shp + 256 * j), sc = *(const f32x4*)(scp + 256 * j); const f32x4 h = v[j] * (sc + 1.0f) + sh;
                u32x2 w; w.x = cvt_pk_bf16(h[0], h[1]); w.y = cvt_pk_bf16(h[2], h[3]); *(u32x2*)(ho + 256 * j) = w; }
        }
        if (H2) {
            const float* shp = adakv + (size_t)ar * 2048 + 4 * lane; const float* scp = shp + 1024;
            bf16_t* ho = H2 + (size_t)row * DM + 4 * lane;
#pragma unroll
            for (int j = 0; j < 4; ++j) { const f32x4 sh = *(const f32x4*)(shp + 256 * j), sc = *(const f32x4*)(scp + 256 * j); const f32x4 h = v[j] * (sc + 1.0f) + sh;
                u32x2 w; w.x = cvt_pk_bf16(h[0], h[1]); w.y = cvt_pk_bf16(h[2], h[3]); *(u32x2*)(ho + 256 * j) = w; }
        }
    }
}

__device__ __forceinline__ int t5_bucket(int rel) {
    const int n = rel < 0 ? -rel : rel; const int base = rel > 0 ? 16 : 0;
    if (n < 8) return base + n;
    int lg = (31 - __builtin_clz((unsigned)(n * n))) - 6 + 8; if (lg > 15) lg = 15;
    return base + lg;
}
constexpr int KS_STRIDE = 72, VT_STRIDE = 68, TAB_STRIDE = 264;
constexpr int LDS_KS = 0, LDS_VT = 2 * 64 * KS_STRIDE * 2, LDS_TAB = LDS_VT + 2 * 64 * VT_STRIDE * 2, LDS_SC = LDS_TAB + 16 * TAB_STRIDE * 4;
static_assert(LDS_SC + 8 * 544 * 4 <= 131072, "attn lds");

template <int MODE> __device__ __forceinline__ void attn_build_tab(unsigned char* lds, const float* src) {
    const int tid = opaque_tid();
    float* tab = (float*)(lds + LDS_TAB);
    if (MODE == 0) { for (int idx = tid; idx < 16 * 256; idx += 512) { const int h = idx >> 8, i = idx & 255; tab[h * TAB_STRIDE + i] = src[t5_bucket(i - 191) * 16 + h] * LOG2E; } }
    else { for (int idx = tid; idx < 16 * 257; idx += 512) { const int h = idx / 257, i = idx - h * 257; tab[h * TAB_STRIDE + i] = src[idx] * LOG2E; } }
    __syncthreads();
}

template <int MODE> __device__ __forceinline__ void attn_prompt(unsigned char* lds, const bf16_t* Q, const bf16_t* KV, bf16_t* O, const float* sinks) {
    const int tid = opaque_tid(), lane = tid & 63, w = __builtin_amdgcn_readfirstlane(tid >> 6);
    constexpr int NBACK = MODE == 0 ? 2 : 8;
    constexpr int LDQ = MODE == 0 ? 1536 : 1024, LDKV = MODE == 0 ? 1536 : 2048;
    bf16_t* Ks = (bf16_t*)(lds + LDS_KS); bf16_t* Vt = (bf16_t*)(lds + LDS_VT); const float* tab = (const float*)(lds + LDS_TAB);
    const int l15 = lane & 15, quad = lane >> 4;
    const int skey = tid >> 3, spart = tid & 7;
    for (int u = blockIdx.x; u < 8192; u += gridDim.x) {
        int b, head, cw, jlo, jhi; const bf16_t* kbase; const bf16_t* vbase;
        if (MODE == 0) { const int hp = u & 1, kvh = (u >> 1) & 3, ci = (u >> 3) & 127; b = u >> 10; head = kvh * 4 + hp * 2 + (w >> 2); cw = ci; jlo = ci - 2 < 0 ? 0 : ci - 2; jhi = ci;
            kbase = KV + (size_t)b * SEQ * LDKV + 1024 + kvh * 64; vbase = kbase + 256; }
        else { head = u & 15; const int cp = (u >> 4) & 63; b = u >> 10; cw = 2 * cp + (w >> 2); jlo = 2 * cp - 8 < 0 ? 0 : 2 * cp - 8; jhi = 2 * cp + 1;
            kbase = KV + (size_t)b * SEQ * LDKV + head * 64; vbase = kbase + 1024; }
        const int qpos = cw * 64 + (w & 3) * 16 + l15;
        const size_t qrow = (size_t)b * SEQ + qpos;
        bf16x8 qf[2];
        qf[0] = *(const bf16x8*)(Q + qrow * LDQ + head * 64 + quad * 8); qf[1] = *(const bf16x8*)(Q + qrow * LDQ + head * 64 + 32 + quad * 8);
        f32x4 o[4];
#pragma unroll
        for (int dt = 0; dt < 4; ++dt) o[dt] = (f32x4){0.f, 0.f, 0.f, 0.f};
        float mrun, lsum;
        if (MODE == 0) { mrun = sinks[head] * LOG2E; lsum = quad == 0 ? 1.0f : 0.0f; } else { mrun = -1e30f; lsum = 0.f; }
        const float* tabh = tab + head * TAB_STRIDE;
        u32x4 kreg = *(const u32x4*)(kbase + (size_t)(jlo * 64 + skey) * LDKV + spart * 8);
        u32x4 vreg = *(const u32x4*)(vbase + (size_t)(jlo * 64 + skey) * LDKV + spart * 8);
        for (int j = jlo; j <= jhi; ++j) {
            const int buf = (j - jlo) & 1;
            { bf16_t* kd = Ks + buf * 64 * KS_STRIDE + skey * KS_STRIDE + spart * 8; *(u32x4*)kd = kreg;
              bf16_t* vd = Vt + buf * 64 * VT_STRIDE + (spart * 8) * VT_STRIDE + skey;
              vd[0 * VT_STRIDE] = (bf16_t)(vreg.x & 0xffff); vd[1 * VT_STRIDE] = (bf16_t)(vreg.x >> 16); vd[2 * VT_STRIDE] = (bf16_t)(vreg.y & 0xffff); vd[3 * VT_STRIDE] = (bf16_t)(vreg.y >> 16);
              vd[4 * VT_STRIDE] = (bf16_t)(vreg.z & 0xffff); vd[5 * VT_STRIDE] = (bf16_t)(vreg.z >> 16); vd[6 * VT_STRIDE] = (bf16_t)(vreg.w & 0xffff); vd[7 * VT_STRIDE] = (bf16_t)(vreg.w >> 16); }
            __syncthreads();
            if (j < jhi) { kreg = *(const u32x4*)(kbase + (size_t)((j + 1) * 64 + skey) * LDKV + spart * 8); vreg = *(const u32x4*)(vbase + (size_t)((j + 1) * 64 + skey) * LDKV + spart * 8); }
            if (j >= cw - NBACK && j <= cw) {
                const bf16_t* kb = Ks + buf * 64 * KS_STRIDE; const bf16_t* vb = Vt + buf * 64 * VT_STRIDE;
                f32x4 s[4];
#pragma unroll
                for (int t = 0; t < 4; ++t) { s[t] = (f32x4){0.f, 0.f, 0.f, 0.f};
#pragma unroll
                    for (int kk = 0; kk < 2; ++kk) { const bf16x8 kf = *(const bf16x8*)(kb + (16 * t + l15) * KS_STRIDE + kk * 32 + quad * 8); s[t] = __builtin_amdgcn_mfma_f32_16x16x32_bf16(kf, qf[kk], s[t], 0, 0, 0); } }
                float mx = -1e30f;
#pragma unroll
                for (int t = 0; t < 4; ++t)
#pragma unroll
                    for (int jj = 0; jj < 4; ++jj) { const int kpos = j * 64 + 16 * t + quad * 4 + jj; int idx;
                        if (MODE == 0) idx = kpos - qpos + 191; else { int d = qpos - kpos; d = d < -128 ? -128 : (d > 128 ? 128 : d); idx = d + 128; }
                        const float v = s[t][jj] * SCALE2 + tabh[idx]; s[t][jj] = v; mx = fmaxf(mx, v); }
                mx = fmaxf(mx, __shfl_xor(mx, 16)); mx = fmaxf(mx, __shfl_xor(mx, 32));
                const float mnew = fmaxf(mrun, mx); const float alpha = __builtin_amdgcn_exp2f(mrun - mnew); mrun = mnew;
                float ps = 0.f;
#pragma unroll
                for (int t = 0; t < 4; ++t)
#pragma unroll
                    for (int jj = 0; jj < 4; ++jj) { const float p = __builtin_amdgcn_exp2f(s[t][jj] - mnew); s[t][jj] = p; ps += p; }
                lsum = lsum * alpha + ps;
#pragma unroll
                for (int dt = 0; dt < 4; ++dt) o[dt] = o[dt] * alpha;
#pragma unroll
                for (int kb2 = 0; kb2 < 2; ++kb2) {
                    u32x4 pw; pw.x = cvt_pk_bf16(s[2 * kb2][0], s[2 * kb2][1]); pw.y = cvt_pk_bf16(s[2 * kb2][2], s[2 * kb2][3]); pw.z = cvt_pk_bf16(s[2 * kb2 + 1][0], s[2 * kb2 + 1][1]); pw.w = cvt_pk_bf16(s[2 * kb2 + 1][2], s[2 * kb2 + 1][3]);
                    const bf16x8 pf = __builtin_bit_cast(bf16x8, pw);
#pragma unroll
                    for (int dt = 0; dt < 4; ++dt) { const bf16_t* vp = vb + (16 * dt + l15) * VT_STRIDE + 32 * kb2 + quad * 4;
                        const u32x2 lo = *(const u32x2*)vp, hi = *(const u32x2*)(vp + 16); u32x4 vw; vw.x = lo.x; vw.y = lo.y; vw.z = hi.x; vw.w = hi.y;
                        o[dt] = __builtin_amdgcn_mfma_f32_16x16x32_bf16(__builtin_bit_cast(bf16x8, vw), pf, o[dt], 0, 0, 0); }
                }
            }
        }
        __syncthreads();
        lsum += __shfl_xor(lsum, 16); lsum += __shfl_xor(lsum, 32);
        const float inv = 1.0f / lsum;
        bf16_t* op = O + qrow * DM + head * 64 + quad * 4;
#pragma unroll
        for (int dt = 0; dt < 4; ++dt) { u32x2 w2; w2.x = cvt_pk_bf16(o[dt][0] * inv, o[dt][1] * inv); w2.y = cvt_pk_bf16(o[dt][2] * inv, o[dt][3] * inv); *(u32x2*)(op + 16 * dt) = w2; }
    }
}

template <int MODE> __device__ __forceinline__ void attn_sample(unsigned char* lds, const bf16_t* Q, const bf16_t* KV, bf16_t* O, const float* ck_all, const float* cv_all,
                                                                const float* tabsrc, const float* sinks) {
    const int tid = opaque_tid(), lane = tid & 63, w = __builtin_amdgcn_readfirstlane(tid >> 6);
    constexpr int P = MODE == 0 ? 128 : 512, NK = P + 16;
    constexpr int LDQ = MODE == 0 ? 1536 : 1024, LDKV = MODE == 0 ? 1536 : 2048, CST = MODE == 0 ? 256 : 1024;
    float* sc = (float*)(lds + LDS_SC) + w * 544;
    const int kq = lane >> 4, dl = lane & 15;
    for (int task = blockIdx.x * 8 + w; task < 2048; task += gridDim.x * 8) {
        const int i = task & 15, head = (task >> 4) & 15, b = task >> 8;
        const size_t srow = (size_t)MP + b * 16 + i;
        const float* ck; const float* cv; const bf16_t* nk; const bf16_t* nv;
        if (MODE == 0) { const int kvh = head >> 2; ck = ck_all + ((size_t)b * 128 * 4 + kvh) * 64; cv = cv_all + ((size_t)b * 128 * 4 + kvh) * 64; nk = KV + ((size_t)MP + b * 16) * LDKV + 1024 + kvh * 64; nv = nk + 256; }
        else { ck = ck_all + ((size_t)b * 512 * 16 + head) * 64; cv = cv_all + ((size_t)b * 512 * 16 + head) * 64; nk = KV + ((size_t)MP + b * 16) * LDKV + head * 64; nv = nk + 1024; }
        f32x4 q4; { const u32x2 qw = *(const u32x2*)(Q + srow * LDQ + head * 64 + 4 * dl); q4[0] = bf2f(qw.x & 0xffff); q4[1] = bf2f(qw.x >> 16); q4[2] = bf2f(qw.y & 0xffff); q4[3] = bf2f(qw.y >> 16); }
        for (int g = 0; g < NK / 4; ++g) {
            const int key = 4 * g + kq; f32x4 k4;
            if (key < P) k4 = *(const f32x4*)(ck + (size_t)key * CST + 4 * dl);
            else { const u32x2 kw = *(const u32x2*)(nk + (size_t)(key - P) * LDKV + 4 * dl); k4[0] = bf2f(kw.x & 0xffff); k4[1] = bf2f(kw.x >> 16); k4[2] = bf2f(kw.y & 0xffff); k4[3] = bf2f(kw.y >> 16); }
            float part = (q4[0] * k4[0] + q4[1] * k4[1]) + (q4[2] * k4[2] + q4[3] * k4[3]);
            part += __shfl_xor(part, 1); part += __shfl_xor(part, 2); part += __shfl_xor(part, 4); part += __shfl_xor(part, 8);
            if (dl == 0) { float bias;
                if (MODE == 0) bias = tabsrc[t5_bucket(key - 128 - i) * 16 + head];
                else { int d = (2048 + i) - (1536 + key); d = d < -128 ? -128 : (d > 128 ? 128 : d); bias = tabsrc[head * 257 + d + 128]; }
                sc[key] = part * 0.125f + bias; }
        }
        asm volatile("s_waitcnt lgkmcnt(0)" ::: "memory");
        float mx = MODE == 0 ? sinks[head] : -1e30f;
        for (int key = lane; key < NK; key += 64) mx = fmaxf(mx, sc[key]);
        mx = wave_max(mx);
        float sum = 0.f;
        for (int key = lane; key < NK; key += 64) { const float e = __expf(sc[key] - mx); sc[key] = e; sum += e; }
        sum = wave_sum(sum);
        if (MODE == 0) sum += __expf(sinks[head] - mx);
        asm volatile("s_waitcnt lgkmcnt(0)" ::: "memory");
        f32x4 acc = (f32x4){0.f, 0.f, 0.f, 0.f};
        for (int g = 0; g < NK / 4; ++g) {
            const int key = 4 * g + kq; f32x4 v4;
            if (key < P) v4 = *(const f32x4*)(cv + (size_t)key * CST + 4 * dl);
            else { const u32x2 kw = *(const u32x2*)(nv + (size_t)(key - P) * LDKV + 4 * dl); v4[0] = bf2f(kw.x & 0xffff); v4[1] = bf2f(kw.x >> 16); v4[2] = bf2f(kw.y & 0xffff); v4[3] = bf2f(kw.y >> 16); }
            acc = acc + v4 * sc[key];
        }
#pragma unroll
        for (int j = 0; j < 4; ++j) { acc[j] += __shfl_xor(acc[j], 16); acc[j] += __shfl_xor(acc[j], 32); }
        const float inv = 1.0f / sum;
        if (kq == 0) { u32x2 w2; w2.x = cvt_pk_bf16(acc[0] * inv, acc[1] * inv); w2.y = cvt_pk_bf16(acc[2] * inv, acc[3] * inv); *(u32x2*)(O + srow * DM + head * 64 + 4 * dl) = w2; }
        asm volatile("s_waitcnt lgkmcnt(0)" ::: "memory");
    }
}

__device__ __forceinline__ void conv_act4(const f32x4 (&ua)[3], const f32x4 (&ug)[3], const float* cw, const float* cb, int c, bf16_t* dst) {
    const f32x4 ya = *(const f32x4*)(cb + c) + *(const f32x4*)(cw + 2 * FF2 + c) * ua[0] + *(const f32x4*)(cw + FF2 + c) * ua[1] + *(const f32x4*)(cw + c) * ua[2];
    const f32x4 yg = *(const f32x4*)(cb + FF + c) + *(const f32x4*)(cw + 2 * FF2 + FF + c) * ug[0] + *(const f32x4*)(cw + FF2 + FF + c) * ug[1] + *(const f32x4*)(cw + FF + c) * ug[2];
    u32x2 w; w.x = cvt_pk_bf16(gelu_tanh(yg[0]) * ya[0], gelu_tanh(yg[1]) * ya[1]); w.y = cvt_pk_bf16(gelu_tanh(yg[2]) * ya[2], gelu_tanh(yg[3]) * ya[3]);
    *(u32x2*)dst = w;
}
__device__ __forceinline__ void fixup_phase(const Params& P, int l) {
    const int tid = opaque_tid();
    const float* UH = (const float*)(P.ws + WS_UH); const float* US = (const float*)(P.ws + WS_USAMP); bf16_t* ACT = (bf16_t*)(P.ws + WS_ACT);
    const float* cw = P.in[24] + (size_t)l * 3 * FF2; const float* cb = P.in[25] + (size_t)l * FF2;
    const float* st = P.in[8] + (size_t)l * 8 * 2 * FF2; float* cvs = P.out + O_CVS + (size_t)l * 8 * 2 * FF2;
    const int gt = blockIdx.x * 512 + tid, NT = gridDim.x * 512;
    const f32x4 z = (f32x4){0.f, 0.f, 0.f, 0.f};
    for (int idx = gt; idx < 1024 * 2 * 704; idx += NT) {
        const int cq = idx % 704, rr = (idx / 704) & 1, g = idx / 1408, c = 4 * cq;
        const bool first = (g & 127) == 0;
        const float* r0 = UH + ((size_t)g * 4 + rr) * FF2;
        const float* r1 = rr == 0 ? UH + ((size_t)(g - 1) * 4 + 3) * FF2 : UH + ((size_t)g * 4 + 0) * FF2;
        const float* r2 = rr == 0 ? UH + ((size_t)(g - 1) * 4 + 2) * FF2 : UH + ((size_t)(g - 1) * 4 + 3) * FF2;
        f32x4 ua[3], ug[3];
        ua[0] = *(const f32x4*)(r0 + c); ug[0] = *(const f32x4*)(r0 + FF + c);
        if (rr == 0 && first) { ua[1] = z; ug[1] = z; } else { ua[1] = *(const f32x4*)(r1 + c); ug[1] = *(const f32x4*)(r1 + FF + c); }
        if (first) { ua[2] = z; ug[2] = z; } else { ua[2] = *(const f32x4*)(r2 + c); ug[2] = *(const f32x4*)(r2 + FF + c); }
        conv_act4(ua, ug, cw, cb, c, ACT + (size_t)(g * 64 + rr) * FF + c);
    }
    for (int idx = gt; idx < 128 * 704; idx += NT) {
        const int cq = idx % 704, s = idx / 704, c = 4 * cq, b = s >> 4, t = s & 15;
        const float* r0 = US + (size_t)s * FF2;
        const float* r1 = t >= 1 ? US + (size_t)(s - 1) * FF2 : st + (size_t)(b * 2 + 1) * FF2;
        const float* r2 = t >= 2 ? US + (size_t)(s - 2) * FF2 : st + (size_t)(b * 2 + t) * FF2;
        f32x4 ua[3], ug[3];
        ua[0] = *(const f32x4*)(r0 + c); ug[0] = *(const f32x4*)(r0 + FF + c);
        ua[1] = *(const f32x4*)(r1 + c); ug[1] = *(const f32x4*)(r1 + FF + c);
        ua[2] = *(const f32x4*)(r2 + c); ug[2] = *(const f32x4*)(r2 + FF + c);
        conv_act4(ua, ug, cw, cb, c, ACT + (size_t)(MP + s) * FF + c);
        if (t >= 14) { float* d = cvs + (size_t)(b * 2 + (t - 14)) * FF2; *(f32x4*)(d + c) = ua[0]; *(f32x4*)(d + FF + c) = ug[0]; }
    }
}

__global__ void __launch_bounds__(512, 2) yoco_fwd(Params P) {
    extern __shared__ __attribute__((aligned(16))) unsigned char lds[];
    cg::grid_group grid = cg::this_grid();
    unsigned char* ws = P.ws;
    float* out = P.out;
    const float* ada = (const float*)(ws + WS_ADA); const float* adakv = (const float*)(ws + WS_ADAKV);
    bf16_t* H = (bf16_t*)(ws + WS_H); bf16_t* HKV = (bf16_t*)(ws + WS_HKV); bf16_t* QKV = (bf16_t*)(ws + WS_QKV); bf16_t* OB = (bf16_t*)(ws + WS_O);
    bf16_t* KVB = (bf16_t*)(ws + WS_KVB); bf16_t* ACT = (bf16_t*)(ws + WS_ACT);

    p0_ada(lds, P);
    __syncthreads();
    p0_weights(lds, P);
    grid.sync();
    row_pass(P.in[0], P.in[1], false, nullptr, nullptr, nullptr, ada, 0, 1, H, nullptr, nullptr);
    grid.sync();

    for (int sl = 0; sl < 8; ++sl) {
        const int l = sl >> 1; const bool ffn = sl & 1;
        const float* ada_l = ada + (size_t)l * 16 * 6144;
        pg8::Gemm gres;
        if (!ffn) {
            const int npass = (l == 2) ? 2 : 1;
            for (int pass = 0; pass < npass; ++pass) {
                pg8::Gemm g; EpiProj E;
                if (l == 2 && pass == 0) {
                    g = pg8::Gemm{HKV, (const bf16_t*)(ws + WS_WKV), MR, 2048, 1024};
                    E = EpiProj{KVB, 2048, Extra{out + O_BKP, out + O_BKS, 0, 1024, 512}, Extra{out + O_BVP, out + O_BVS, 1024, 1024, 512}};
                } else if (l < 2) {
                    g = pg8::Gemm{H, (const bf16_t*)(ws + WS_WQKV) + (size_t)l * 1536 * 1024, MR, 1536, 1024};
                    E = EpiProj{QKV, 1536, Extra{out + O_AKP + (size_t)l * 8 * 128 * 256, out + O_AKS + (size_t)l * 128 * 256, 1024, 256, 128},
                                Extra{out + O_AVP + (size_t)l * 8 * 128 * 256, out + O_AVS + (size_t)l * 128 * 256, 1280, 256, 128}};
                } else {
                    g = pg8::Gemm{H, (const bf16_t*)(ws + WS_WQB) + (size_t)(l - 2) * 1024 * 1024, MR, 1024, 1024};
                    E = EpiProj{QKV, 1024, Extra{nullptr, nullptr, 0, 0, 0}, Extra{nullptr, nullptr, 0, 0, 0}};
                }
                pg8::StaticOrder S; S.init(g.M, g.N, gridDim.x, blockIdx.x);
                pg8::gemm_phase<EpiProj, pg8::StaticOrder>((LAS unsigned char*)lds, g, S, E);
            }
            grid.sync();
            if (l < 2) {
                attn_sample<0>(lds, QKV, QKV, OB, P.in[4] + (size_t)l * 8 * 128 * 256, P.in[5] + (size_t)l * 8 * 128 * 256, P.in[16], P.in[15] + l * 16);
                attn_build_tab<0>(lds, P.in[16]);
                attn_prompt<0>(lds, QKV, QKV, OB, P.in[15] + l * 16);
            } else {
                attn_sample<1>(lds, QKV, KVB, OB, P.in[6], P.in[7], P.in[22] + (size_t)(l - 2) * 16 * 257, nullptr);
                attn_build_tab<1>(lds, P.in[22] + (size_t)(l - 2) * 16 * 257);
                attn_prompt<1>(lds, QKV, KVB, OB, nullptr);
            }
            grid.sync();
            gres = pg8::Gemm{OB, l < 2 ? (const bf16_t*)(ws + WS_WOA) + (size_t)l * 1024 * 1024 : (const bf16_t*)(ws + WS_WOB) + (size_t)(l - 2) * 1024 * 1024, MR, 1024, 1024};
        } else {
            {
                pg8::Gemm g{H, (const bf16_t*)(ws + WS_WUP) + (size_t)l * FF2 * 1024, MR, FF2, 1024};
                EpiUp E{ACT, (float*)(ws + WS_UH), (float*)(ws + WS_USAMP), P.in[24] + (size_t)l * 3 * FF2, P.in[25] + (size_t)l * FF2, out + O_CVP + (size_t)l * 8 * 2 * FF2};
                pg8::StaticOrder S; S.init(g.M, g.N, gridDim.x, blockIdx.x);
                pg8::gemm_phase<EpiUp, pg8::StaticOrder>((LAS unsigned char*)lds, g, S, E);
            }
            grid.sync();
            fixup_phase(P, l);
            grid.sync();
            gres = pg8::Gemm{ACT, (const bf16_t*)(ws + WS_WDN) + (size_t)l * 1024 * FF, MR, 1024, FF};
        }
        {
            const bool first = (sl == 0);
            EpiRes E{first ? P.in[0] : out, first ? P.in[1] : out + (size_t)MP * DM, out, ada_l + (ffn ? 5 : 2) * 1024};
            pg8::StaticOrder S; S.init(gres.M, gres.N, gridDim.x, blockIdx.x);
            pg8::gemm_phase<EpiRes, pg8::StaticOrder>((LAS unsigned char*)lds, gres, S, E);
        }
        grid.sync();
        {
            const float* lg = P.in[11] + (size_t)(l * 2 + (ffn ? 1 : 0)) * DM; const float* lb = P.in[12] + (size_t)(l * 2 + (ffn ? 1 : 0)) * DM;
            if (!ffn) row_pass(out, out + (size_t)MP * DM, true, lg, lb, out, ada_l, 3, 4, H, nullptr, nullptr);
            else if (l < 3) row_pass(out, out + (size_t)MP * DM, true, lg, lb, out, ada_l + 16 * 6144, 0, 1, H, l == 1 ? adakv : nullptr, l == 1 ? HKV : nullptr);
            else row_pass(out, out + (size_t)MP * DM, true, lg, lb, out, nullptr, 0, 0, nullptr, nullptr, nullptr);
        }
        if (sl < 7) grid.sync();
    }
}

extern "C" void kernel_launch(void* const* d_in, const int* in_sizes, int n_in, void* d_out, int out_size, void* d_ws, size_t ws_size, hipStream_t stream) {
    static int grid = 0;
    if (grid == 0) {
        if (n_in != 27 || (size_t)out_size != O_END || ws_size < WS_END) { fprintf(stderr, "kernel_launch: unexpected shapes: n_in %d out %d (want %zu) ws %zu (need %zu)\n", n_in, out_size, (size_t)O_END, ws_size, (size_t)WS_END); grid = -1; return; }
        int dev = 0, cus = 0, per_cu = 0;
        (void)hipGetDevice(&dev);
        (void)hipDeviceGetAttribute(&cus, hipDeviceAttributeMultiprocessorCount, dev);
        if (hipFuncSetAttribute((const void*)yoco_fwd, hipFuncAttributeMaxDynamicSharedMemorySize, LDS_BYTES) != hipSuccess) { fprintf(stderr, "kernel_launch: hipFuncSetAttribute failed\n"); grid = -1; return; }
        if (hipOccupancyMaxActiveBlocksPerMultiprocessor(&per_cu, (const void*)yoco_fwd, 512, LDS_BYTES) != hipSuccess || per_cu < 1) { fprintf(stderr, "kernel_launch: occupancy query says %d\n", per_cu); per_cu = 1; }
        (void)hipGetLastError();
        grid = cus;
    }
    if (grid < 0) return;
    Params p{};
    for (int i = 0; i < 27; ++i) p.in[i] = (const float*)d_in[i];
    p.out = (float*)d_out; p.ws = (unsigned char*)d_ws;
    void* args[] = {&p};
    hipError_t e = hipLaunchCooperativeKernel((const void*)yoco_fwd, dim3(grid), dim3(512), args, LDS_BYTES, stream);
    if (e != hipSuccess) fprintf(stderr, "kernel_launch: cooperative launch failed: %s (grid %d)\n", hipGetErrorString(e), grid);
}
```

```cpp
#include <hip/hip_runtime.h>
#include <hip/hip_cooperative_groups.h>
#include <cstdio>
#include <cstdint>
namespace cg = cooperative_groups;

#define LAS __attribute__((address_space(3)))
typedef unsigned short bf16_t;
typedef short bf16x8 __attribute__((ext_vector_type(8)));
typedef float f32x4 __attribute__((ext_vector_type(4)));
typedef unsigned u32x4 __attribute__((ext_vector_type(4)));
typedef unsigned u32x2 __attribute__((ext_vector_type(2)));

constexpr int DM = 1024, SEQ = 8192, NBATCH = 8, MP = NBATCH * SEQ, MS = 128, MREAL = MP + MS, MR = 65792;
constexpr int FF = 2816, FF2 = 5632;
constexpr float ALPHA = 1.681792830507429f;
constexpr float LN_EPS = 1e-5f;
constexpr float LOG2E = 1.4426950408889634f;
constexpr float SCALE2 = 0.125f * LOG2E;

constexpr size_t O_Y = 0;
constexpr size_t O_AKP = (size_t)MREAL * DM;
constexpr size_t O_AVP = O_AKP + 2 * 8 * 128 * 256;
constexpr size_t O_BKP = O_AVP + 2 * 8 * 128 * 256;
constexpr size_t O_BVP = O_BKP + (size_t)8 * 512 * 1024;
constexpr size_t O_CVP = O_BVP + (size_t)8 * 512 * 1024;
constexpr size_t O_AKS = O_CVP + 4 * 8 * 2 * FF2;
constexpr size_t O_AVS = O_AKS + 2 * 128 * 256;
constexpr size_t O_BKS = O_AVS + 2 * 128 * 256;
constexpr size_t O_BVS = O_BKS + 128 * 1024;
constexpr size_t O_CVS = O_BVS + 128 * 1024;
constexpr size_t O_END = O_CVS + 4 * 8 * 2 * FF2;

constexpr size_t MiB = 1u << 20;
constexpr size_t WS_WQKV = 1 * MiB, WS_WOA = 7 * MiB, WS_WKV = 11 * MiB, WS_WQB = 15 * MiB, WS_WOB = 19 * MiB, WS_WUP = 23 * MiB, WS_WDN = 67 * MiB;
constexpr size_t WS_ADA = 89 * MiB, WS_ADAKV = 90 * MiB + 512 * 1024, WS_USAMP = 91 * MiB, WS_UH = 94 * MiB;
constexpr size_t WS_H = 183 * MiB, WS_KVB = 312 * MiB, WS_R = 569 * MiB;
constexpr size_t WS_QKV = WS_R, WS_O = WS_R + 193 * MiB, WS_HKV = WS_R + 224 * MiB, WS_ACT = WS_R, WS_END = 923 * MiB;
static_assert(WS_UH + (size_t)1024 * 4 * FF2 * 4 <= WS_H, "uh");
static_assert(WS_H + (size_t)MR * DM * 2 <= WS_KVB, "h");
static_assert(WS_KVB + (size_t)MR * 2048 * 2 <= WS_R, "kvb");
static_assert(WS_ACT + (size_t)MR * FF * 2 <= WS_END && WS_HKV + (size_t)MR * DM * 2 <= WS_END && WS_QKV + (size_t)MR * 1536 * 2 <= WS_O && WS_O + (size_t)MR * DM * 2 <= WS_END, "r");

constexpr int LDS_BYTES = 147456;

struct Params { const float* in[27]; float* out; unsigned char* ws; };

__device__ __forceinline__ int opaque_tid() { int t = threadIdx.x; asm volatile("" : "+v"(t)); return t; }
__device__ __forceinline__ unsigned cvt_pk_bf16(float lo, float hi) { unsigned r; asm volatile("v_cvt_pk_bf16_f32 %0, %1, %2" : "=v"(r) : "v"(lo), "v"(hi)); return r; }
__device__ __forceinline__ float bf2f(unsigned short h) { return __builtin_bit_cast(float, (unsigned)h << 16); }
__device__ __forceinline__ int ada_row(int row) { int r = row < MP ? (row >> 13) : 8 + ((row - MP) >> 4); return r > 15 ? 15 : r; }
__device__ __forceinline__ float gelu_tanh(float x) {
    const float z = 0.7978845608028654f * (x + 0.044715f * x * x * x);
    const float t = __builtin_amdgcn_exp2f(z * (2.0f * LOG2E));
    return x - x * __builtin_amdgcn_rcpf(1.0f + t);
}
__device__ __forceinline__ float wave_sum(float v) {
#pragma unroll
    for (int o = 1; o < 64; o <<= 1) v += __shfl_xor(v, o);
    return v;
}
__device__ __forceinline__ float wave_max(float v) {
#pragma unroll
    for (int o = 1; o < 64; o <<= 1) v = fmaxf(v, __shfl_xor(v, o));
    return v;
}

namespace pg8 {
constexpr int BM = 256, BK = 64, HALF = 128, HTB = HALF * BK * 2, STAGE_BYTES = 8 * HTB, NXCD = 8, WGM = 8;
__host__ __device__ __forceinline__ int lds_byte(int r, int c) { const int st = (r >> 4) * 2 + (c >> 5), rr = r & 15, cc = c & 31, ob = rr * 64 + cc * 2; return st * 1024 + (ob ^ (((ob >> 9) & 1) << 5)); }
__host__ __device__ __forceinline__ void stage_rc(int b, int& R, int& C) { const int st = b / 1024, sb = b % 1024, swz = sb ^ (((sb >> 9) & 1) << 5); R = (st >> 1) * 16 + swz / 64; C = (st & 1) * 32 + (swz % 64) / 2; }
__host__ __device__ __forceinline__ int perm32(int rho) { const int n = rho >> 4, i = rho & 15; return 8 * (i >> 2) + 4 * n + (i & 3); }

struct Unit { int pm, pn; };
struct Gemm { const bf16_t* A; const bf16_t* Bt; int M, N, K; };

struct StaticOrder {
    int nM, nN, nwg, G, c;
    __device__ void init(int M, int N, int G_, int c_) { nM = M / BM; nN = N / BM; nwg = nM * nN; G = G_; c = c_; }
    __device__ bool next(int i, Unit& u) const {
        const long L = (long)i * G + c; if (L >= nwg) return false;
        int wgid = (int)L; { const int q = nwg / NXCD, r = nwg % NXCD, xcd = wgid % NXCD, off = wgid / NXCD; wgid = (xcd < r ? xcd * (q + 1) : r * (q + 1) + (xcd - r) * q) + off; }
        const int nig = WGM * nN, gid = wgid / nig, fm = gid * WGM, gsz = (nM - fm) < WGM ? (nM - fm) : WGM;
        u.pm = fm + ((wgid % nig) % gsz); u.pn = (wgid % nig) / gsz; return true;
    }
};

template <class Epi, class Sched>
__device__ __forceinline__ void gemm_phase(LAS unsigned char* lds, const Gemm g, const Sched& S, const Epi& E) {
    const int tid = opaque_tid(), wid = __builtin_amdgcn_readfirstlane(tid >> 6), lane = tid & 63, wr = wid >> 2, wc = wid & 3, fr = lane & 15, fq = lane >> 4;
    const int K = g.K, nt = K / BK;
    unsigned voffA[2], voffB[2];
#pragma unroll
    for (int i = 0; i < 2; ++i) { int R, C; stage_rc(tid * 16 + i * 8192, R, C); const int Rb = Epi::PERM ? ((R & ~31) + perm32(R & 31)) : R;
        const int Ra = Epi::ROWPERM ? ((R & 64) | ((R & 15) << 2) | ((R >> 4) & 3)) : R;
        voffA[i] = (unsigned)(Ra * K + C) * 2u; voffB[i] = (unsigned)(Rb * K + C) * 2u; }
    const size_t kstep = (size_t)(BK * 2);
    const size_t hstep = (size_t)HALF * K * 2;
    const size_t tstep = 2 * hstep;
    const unsigned ldsw = (unsigned)wid * 1024u;
    const int aoff = lds_byte(wr * 64 + fr, fq * 8), boff = lds_byte(wc * 32 + fr, fq * 8);
#define PG8_SA(b, h) (((b) * 2 + (h)) * HTB)
#define PG8_SB(b, h) ((4 + (b) * 2 + (h)) * HTB)
#define PG8_STAGE(bufoff, gbase, voff) do { _Pragma("unroll") for (int _i = 0; _i < 2; ++_i) \
        __builtin_amdgcn_global_load_lds((const unsigned*)((const char*)(gbase) + (voff)[_i]), (LAS unsigned*)(lds + (bufoff) + ldsw + _i * 8192), 16, 0, 0); } while (0)
#define PG8_LDA(dst, b, h) do { _Pragma("unroll") for (int m = 0; m < 4; ++m) _Pragma("unroll") for (int k = 0; k < 2; ++k) dst[m][k] = *(const LAS bf16x8*)(lds + PG8_SA(b, h) + aoff + m * 2048 + k * 1024); } while (0)
#define PG8_LDB(dst, b, h) do { _Pragma("unroll") for (int n = 0; n < 2; ++n) _Pragma("unroll") for (int k = 0; k < 2; ++k) dst[n][k] = *(const LAS bf16x8*)(lds + PG8_SB(b, h) + boff + n * 2048 + k * 1024); } while (0)
#define PG8_MMA(ai, bj, At, Bt) do { __builtin_amdgcn_s_setprio(1); _Pragma("unroll") for (int m = 0; m < 4; ++m) _Pragma("unroll") for (int n = 0; n < 2; ++n) _Pragma("unroll") for (int k = 0; k < 2; ++k) \
        acc[ai][bj][m][n] = __builtin_amdgcn_mfma_f32_16x16x32_bf16(Bt[n][k], At[m][k], acc[ai][bj][m][n], 0, 0, 0); __builtin_amdgcn_s_setprio(0); } while (0)
#define PG8_WAIT_V(n) asm volatile("s_waitcnt vmcnt(" #n ")" ::: "memory")
#define PG8_WAIT_L(n) asm volatile("s_waitcnt lgkmcnt(" #n ")" ::: "memory")
#define PG8_BAR __builtin_amdgcn_s_barrier()
#define PG8_SCHED __builtin_amdgcn_sched_barrier(0)
    Unit cur, nxt; int ui = 0;
    if (!S.next(0, cur)) return;
    f32x4 acc[2][2][4][2];
#pragma unroll
    for (int a = 0; a < 2; ++a)
#pragma unroll
        for (int b = 0; b < 2; ++b)
#pragma unroll
            for (int m = 0; m < 4; ++m)
#pragma unroll
                for (int n = 0; n < 2; ++n) acc[a][b][m][n] = (f32x4){0.f, 0.f, 0.f, 0.f};
    bf16x8 At[4][2], B0[2][2], B1[2][2];
    const char* cA = (const char*)g.A + (size_t)cur.pm * tstep; const char* cB = (const char*)g.Bt + (size_t)cur.pn * tstep;
    PG8_STAGE(PG8_SB(0, 0), cB, voffB); PG8_STAGE(PG8_SB(0, 1), cB + hstep, voffB); PG8_STAGE(PG8_SA(0, 0), cA, voffA); PG8_STAGE(PG8_SA(0, 1), cA + hstep, voffA);
    if (wr == 1) PG8_BAR;
    PG8_WAIT_V(2); PG8_BAR;
    PG8_STAGE(PG8_SB(1, 0), cB + kstep, voffB); PG8_STAGE(PG8_SA(1, 0), cA + kstep, voffA); PG8_STAGE(PG8_SB(1, 1), cB + hstep + kstep, voffB);
    PG8_WAIT_V(6); PG8_BAR;
    for (;;) {
        const bool has_next = S.next(ui + 1, nxt);
        const char* nA = has_next ? (const char*)g.A + (size_t)nxt.pm * tstep : cA; const char* nB = has_next ? (const char*)g.Bt + (size_t)nxt.pn * tstep : cB;
        for (int t = 0; t < nt; t += 2) {
            const bool last = (t == nt - 2);
            const char* a1 = cA + (size_t)(t + 1) * kstep;
            const char* a2 = last ? nA : cA + (size_t)(t + 2) * kstep; const char* b2 = last ? nB : cB + (size_t)(t + 2) * kstep;
            const char* a3 = a2 + kstep; const char* b3 = b2 + kstep;
            PG8_LDB(B0, 0, 0); PG8_LDB(B1, 0, 1); PG8_SCHED; PG8_LDA(At, 0, 0); PG8_STAGE(PG8_SA(1, 1), a1 + hstep, voffA);
            PG8_WAIT_V(8); PG8_WAIT_L(0); PG8_BAR; PG8_MMA(0, 0, At, B0); PG8_MMA(0, 1, At, B1); PG8_BAR; PG8_SCHED;
            PG8_LDA(At, 0, 1); PG8_STAGE(PG8_SB(0, 0), b2, voffB); PG8_STAGE(PG8_SB(0, 1), b2 + hstep, voffB); PG8_STAGE(PG8_SA(0, 0), a2, voffA);
            PG8_WAIT_V(8); PG8_WAIT_L(0); PG8_BAR; PG8_MMA(1, 0, At, B0); PG8_MMA(1, 1, At, B1); PG8_BAR; PG8_SCHED;
            PG8_LDB(B0, 1, 0); PG8_LDB(B1, 1, 1); PG8_SCHED; PG8_LDA(At, 1, 0); PG8_STAGE(PG8_SA(0, 1), a2 + hstep, voffA);
            PG8_WAIT_V(8); PG8_WAIT_L(0); PG8_BAR; PG8_MMA(0, 0, At, B0); PG8_MMA(0, 1, At, B1); PG8_BAR; PG8_SCHED;
            PG8_LDA(At, 1, 1); PG8_STAGE(PG8_SB(1, 0), b3, voffB); PG8_STAGE(PG8_SB(1, 1), b3 + hstep, voffB); PG8_STAGE(PG8_SA(1, 0), a3, voffA);
            PG8_WAIT_V(8); PG8_WAIT_L(0); PG8_BAR; PG8_MMA(1, 0, At, B0); PG8_MMA(1, 1, At, B1); PG8_BAR; PG8_SCHED;
        }
        if (wr == 0) PG8_BAR;
        E(acc, cur, wr, wc, fr, fq);
        if (!has_next) break;
#pragma unroll
        for (int a = 0; a < 2; ++a)
#pragma unroll
            for (int b = 0; b < 2; ++b)
#pragma unroll
                for (int m = 0; m < 4; ++m)
#pragma unroll
                    for (int n = 0; n < 2; ++n) acc[a][b][m][n] = (f32x4){0.f, 0.f, 0.f, 0.f};
        cur = nxt; cA = nA; cB = nB; ++ui;
        if (wr == 1) PG8_BAR;
    }
    PG8_WAIT_V(0);
    PG8_BAR;
#undef PG8_SA
#undef PG8_SB
#undef PG8_STAGE
#undef PG8_LDA
#undef PG8_LDB
#undef PG8_MMA
#undef PG8_WAIT_V
#undef PG8_WAIT_L
#undef PG8_BAR
#undef PG8_SCHED
}
}

struct Extra { float* pp; float* ps; int c0, width, keep; };

struct EpiProj {
    static constexpr bool PERM = true, ROWPERM = false;
    bf16_t* O; int ldc; Extra e0, e1;
    __device__ __forceinline__ void operator()(const f32x4 (&acc)[2][2][4][2], const pg8::Unit& u, int wr, int wc, int fr, int fq) const {
        const int colt = u.pn * 256;
        const int col0 = colt + wc * 32 + 8 * fq;
        float* xp = nullptr; float* xs = nullptr; int xc0 = 0, xw = 0, xkeep = 0;
        if (e0.width && colt >= e0.c0 && colt < e0.c0 + e0.width) { xp = e0.pp; xs = e0.ps; xc0 = e0.c0; xw = e0.width; xkeep = e0.keep; }
        else if (e1.width && colt >= e1.c0 && colt < e1.c0 + e1.width) { xp = e1.pp; xs = e1.ps; xc0 = e1.c0; xw = e1.width; xkeep = e1.keep; }
#pragma unroll
        for (int ai = 0; ai < 2; ++ai) {
            if (u.pm == 256 && ai == 1) continue;
#pragma unroll
            for (int m = 0; m < 4; ++m) {
                const int row = u.pm * 256 + ai * 128 + wr * 64 + m * 16 + fr;
                bf16_t* rowp = O + (size_t)row * ldc + col0;
#pragma unroll
                for (int bj = 0; bj < 2; ++bj) {
                    const f32x4 v0 = acc[ai][bj][m][0], v1 = acc[ai][bj][m][1];
                    u32x4 w; w.x = cvt_pk_bf16(v0[0], v0[1]); w.y = cvt_pk_bf16(v0[2], v0[3]); w.z = cvt_pk_bf16(v1[0], v1[1]); w.w = cvt_pk_bf16(v1[2], v1[3]);
                    *(u32x4*)(rowp + bj * 128) = w;
                }
                if (xw) {
                    float* d = nullptr;
                    if (row < MP) { const int t = row & (SEQ - 1), b = row >> 13; if (t >= SEQ - xkeep) d = xp + (size_t)(b * xkeep + t - (SEQ - xkeep)) * xw; }
                    else d = xs + (size_t)(row - MP) * xw;
                    if (d) { d += col0 - xc0;
#pragma unroll
                        for (int bj = 0; bj < 2; ++bj) { *(f32x4*)(d + bj * 128) = acc[ai][bj][m][0]; *(f32x4*)(d + bj * 128 + 4) = acc[ai][bj][m][1]; } }
                }
            }
        }
    }
};

struct EpiRes {
    static constexpr bool PERM = false, ROWPERM = false;
    const float* xp; const float* xs; float* out; const float* gate;
    __device__ __forceinline__ void operator()(const f32x4 (&acc)[2][2][4][2], const pg8::Unit& u, int wr, int wc, int fr, int fq) const {
        const int col0 = u.pn * 256 + wc * 32 + 4 * fq;
#pragma unroll
        for (int ai = 0; ai < 2; ++ai) {
            if (u.pm == 256 && ai == 1) continue;
#pragma unroll
            for (int m = 0; m < 4; ++m) {
                const int row = u.pm * 256 + ai * 128 + wr * 64 + m * 16 + fr;
                const float* xr = (row < MP ? xp + (size_t)row * DM : xs + (size_t)(row - MP) * DM) + col0;
                const float* gr = gate + ada_row(row) * 6144 + col0;
                float* orow = out + (size_t)row * DM + col0;
#pragma unroll
                for (int bj = 0; bj < 2; ++bj)
#pragma unroll
                    for (int n = 0; n < 2; ++n) {
                        const int c = bj * 128 + n * 16;
                        const f32x4 xv = *(const f32x4*)(xr + c), gv = *(const f32x4*)(gr + c);
                        *(f32x4*)(orow + c) = xv * ALPHA + (gv + 1.0f) * acc[ai][bj][m][n];
                    }
            }
        }
    }
};

struct EpiUp {
    static constexpr bool PERM = true, ROWPERM = true;
    bf16_t* ACT; float* UH; float* USAMP; const float* cw; const float* cb; float* convp;
    __device__ __forceinline__ void operator()(const f32x4 (&acc)[2][2][4][2], const pg8::Unit& u, int wr, int wc, int fr, int fq) const {
        const int ca0 = u.pn * 128 + wc * 32 + 8 * fq;
        if (u.pm == 256) {
#pragma unroll
            for (int m = 0; m < 4; ++m) { float* d = USAMP + (size_t)(wr * 64 + 4 * fr + m) * FF2 + ca0;
#pragma unroll
                for (int bj = 0; bj < 2; ++bj) { *(f32x4*)(d + bj * FF) = acc[0][bj][m][0]; *(f32x4*)(d + bj * FF + 4) = acc[0][bj][m][1]; } }
            return;
        }
#pragma unroll
        for (int n = 0; n < 2; ++n) {
            const int ca = ca0 + 4 * n;
            f32x4 w0[2], w1[2], w2[2], bb[2];
#pragma unroll
            for (int bj = 0; bj < 2; ++bj) { const int c = bj * FF + ca; w0[bj] = *(const f32x4*)(cw + c); w1[bj] = *(const f32x4*)(cw + FF2 + c); w2[bj] = *(const f32x4*)(cw + 2 * FF2 + c); bb[bj] = *(const f32x4*)(cb + c); }
#pragma unroll
            for (int ai = 0; ai < 2; ++ai) {
                f32x4 p2[2], p3[2];
#pragma unroll
                for (int bj = 0; bj < 2; ++bj)
#pragma unroll
                    for (int j = 0; j < 4; ++j) { p2[bj][j] = __shfl_up(acc[ai][bj][2][n][j], 1, 16); p3[bj][j] = __shfl_up(acc[ai][bj][3][n][j], 1, 16); }
                const int grp = u.pm * 4 + ai * 2 + wr;
                const int row0 = grp * 64 + 4 * fr;
#pragma unroll
                for (int m = 0; m < 4; ++m) {
                    const bool halo = (fr == 0 && m < 2) || (fr == 15 && m >= 2);
                    if (halo) { float* d = UH + ((size_t)(grp * 4 + m)) * FF2 + ca;
                        *(f32x4*)(d) = acc[ai][0][m][n]; *(f32x4*)(d + FF) = acc[ai][1][m][n]; }
                    if (fr == 15 && m >= 2 && ai == 1 && wr == 1 && (u.pm & 31) == 31) { float* d = convp + (size_t)((u.pm >> 5) * 2 + (m - 2)) * FF2 + ca;
                        *(f32x4*)(d) = acc[ai][0][m][n]; *(f32x4*)(d + FF) = acc[ai][1][m][n]; }
                    if (fr == 0 && m < 2) continue;
                    f32x4 y[2];
#pragma unroll
                    for (int bj = 0; bj < 2; ++bj) {
                        const f32x4 u0 = acc[ai][bj][m][n];
                        const f32x4 u1 = (m >= 1) ? acc[ai][bj][m >= 1 ? m - 1 : 0][n] : p3[bj];
                        const f32x4 u2 = (m >= 2) ? acc[ai][bj][m >= 2 ? m - 2 : 0][n] : (m == 1 ? p3[bj] : p2[bj]);
                        y[bj] = bb[bj] + w2[bj] * u0 + w1[bj] * u1 + w0[bj] * u2;
                    }
                    float a0 = gelu_tanh(y[1][0]) * y[0][0], a1 = gelu_tanh(y[1][1]) * y[0][1], a2 = gelu_tanh(y[1][2]) * y[0][2], a3 = gelu_tanh(y[1][3]) * y[0][3];
                    u32x2 w; w.x = cvt_pk_bf16(a0, a1); w.y = cvt_pk_bf16(a2, a3);
                    *(u32x2*)(ACT + (size_t)(row0 + m) * FF + ca) = w;
                }
            }
        }
    }
};

__device__ __forceinline__ void p0_ada(unsigned char* lds, const Params& P) {
    const int tid = opaque_tid(), lane = tid & 63, w = __builtin_amdgcn_readfirstlane(tid >> 6);
    float* scT = (float*)lds;
    float* red = scT + 16384;
    const float* cp = P.in[2]; const float* cs = P.in[3];
    for (int idx = tid; idx < 16384; idx += 512) { const int r = idx >> 10, k = idx & 1023; const float c = r < 8 ? cp[r * 1024 + k] : cs[(r - 8) * 1024 + k]; scT[k * 16 + r] = c / (1.0f + __expf(-c)); }
    __syncthreads();
    float* ada = (float*)(P.ws + WS_ADA); float* adakv = (float*)(P.ws + WS_ADAKV);
    for (int item = blockIdx.x; item < 416; item += gridDim.x) {
        { const int gc = item * 64 + lane; const float* W; int ldw;
          if (gc < 24576) { const int l = gc / 6144, n = gc - l * 6144; W = P.in[9] + (size_t)l * 1024 * 6144 + n; ldw = 6144; }
          else { W = P.in[17] + (gc - 24576); ldw = 2048; }
          float acc[16];
#pragma unroll
          for (int r = 0; r < 16; ++r) acc[r] = 0.f;
#pragma unroll 8
          for (int kk = 0; kk < 128; ++kk) { const int k = w * 128 + kk; const float wv = W[(size_t)k * ldw];
              const f32x4 s0 = *(const f32x4*)(scT + k * 16), s1 = *(const f32x4*)(scT + k * 16 + 4), s2 = *(const f32x4*)(scT + k * 16 + 8), s3 = *(const f32x4*)(scT + k * 16 + 12);
#pragma unroll
              for (int j = 0; j < 4; ++j) { acc[j] += s0[j] * wv; acc[4 + j] += s1[j] * wv; acc[8 + j] += s2[j] * wv; acc[12 + j] += s3[j] * wv; } }
#pragma unroll
          for (int r = 0; r < 16; ++r) red[(w * 16 + r) * 64 + lane] = acc[r]; }
        __syncthreads();
        for (int idx = tid; idx < 1024; idx += 512) { const int r = idx >> 6, cl = idx & 63; float s = 0.f;
#pragma unroll
            for (int ww = 0; ww < 8; ++ww) s += red[(ww * 16 + r) * 64 + cl];
            const int gc = item * 64 + cl;
            if (gc < 24576) { const int l = gc / 6144, n = gc - l * 6144; ada[(size_t)(l * 16 + r) * 6144 + n] = s + P.in[10][l * 6144 + n]; }
            else { const int n = gc - 24576; adakv[r * 2048 + n] = s + P.in[18][n]; } }
        __syncthreads();
    }
}

__device__ __forceinline__ int upmap(int n) { return n < FF ? (n >> 7) * 256 + (n & 127) : ((n - FF) >> 7) * 256 + 128 + ((n - FF) & 127); }

__device__ __forceinline__ void p0_transpose_item(const float* W, int K, int N, bf16_t* WT, int up, float* scr, int item, int lane) {
    const int nblk = N / 32, kb = item / nblk, nb = item % nblk, k0 = 64 * kb, n0 = 32 * nb;
    const int d0 = up ? upmap(n0) : n0;
#pragma unroll 8
    for (int i = 0; i < 32; ++i) { const int kk = 2 * i + (lane >> 5); scr[kk * 33 + (lane & 31)] = W[(size_t)(k0 + kk) * N + n0 + (lane & 31)]; }
    asm volatile("s_waitcnt lgkmcnt(0)" ::: "memory");
    const int c = lane & 7;
#pragma unroll
    for (int j = 0; j < 4; ++j) { const int n = (lane >> 3) + 8 * j; const float* s = scr + (8 * c) * 33 + n;
        u32x4 o; o.x = cvt_pk_bf16(s[0 * 33], s[1 * 33]); o.y = cvt_pk_bf16(s[2 * 33], s[3 * 33]); o.z = cvt_pk_bf16(s[4 * 33], s[5 * 33]); o.w = cvt_pk_bf16(s[6 * 33], s[7 * 33]);
        *(u32x4*)(WT + (size_t)(d0 + n) * K + k0 + 8 * c) = o; }
    asm volatile("s_waitcnt lgkmcnt(0)" ::: "memory");
}

__device__ __forceinline__ void p0_weights(unsigned char* lds, const Params& P) {
    const int tid = opaque_tid(), lane = tid & 63, w = __builtin_amdgcn_readfirstlane(tid >> 6);
    float* scr = (float*)(lds + w * 16384);
    const int gw = blockIdx.x * 8 + w, NGW = gridDim.x * 8;
    unsigned char* ws = P.ws;
    for (int it = gw; it < 22528; it += NGW) {
        int r = it;
        if (r < 1536) { const int l = r / 768; r -= l * 768; p0_transpose_item(P.in[13] + (size_t)l * 1024 * 1536, 1024, 1536, (bf16_t*)(ws + WS_WQKV) + (size_t)l * 1536 * 1024, 0, scr, r, lane); continue; } r -= 1536;
        if (r < 1024) { const int l = r / 512; r -= l * 512; p0_transpose_item(P.in[14] + (size_t)l * 1024 * 1024, 1024, 1024, (bf16_t*)(ws + WS_WOA) + (size_t)l * 1024 * 1024, 0, scr, r, lane); continue; } r -= 1024;
        if (r < 1024) { p0_transpose_item(P.in[19], 1024, 2048, (bf16_t*)(ws + WS_WKV), 0, scr, r, lane); continue; } r -= 1024;
        if (r < 1024) { const int l = r / 512; r -= l * 512; p0_transpose_item(P.in[20] + (size_t)l * 1024 * 1024, 1024, 1024, (bf16_t*)(ws + WS_WQB) + (size_t)l * 1024 * 1024, 0, scr, r, lane); continue; } r -= 1024;
        if (r < 1024) { const int l = r / 512; r -= l * 512; p0_transpose_item(P.in[21] + (size_t)l * 1024 * 1024, 1024, 1024, (bf16_t*)(ws + WS_WOB) + (size_t)l * 1024 * 1024, 0, scr, r, lane); continue; } r -= 1024;
        if (r < 11264) { const int l = r / 2816; r -= l * 2816; p0_transpose_item(P.in[23] + (size_t)l * 1024 * FF2, 1024, FF2, (bf16_t*)(ws + WS_WUP) + (size_t)l * FF2 * 1024, 1, scr, r, lane); continue; } r -= 11264;
        { const int l = r / 1408; r -= l * 1408; p0_transpose_item(P.in[26] + (size_t)l * FF * 1024, FF, 1024, (bf16_t*)(ws + WS_WDN) + (size_t)l * 1024 * FF, 0, scr, r, lane); }
    }
}

__device__ __forceinline__ void row_pass(const float* srcp, const float* srcs, bool do_ln, const float* lg, const float* lb, float* xout,
                                         const float* ada_l, int sh_chunk, int sc_chunk, bf16_t* H, const float* adakv, bf16_t* H2) {
    const int tid = opaque_tid(), lane = tid & 63, w = __builtin_amdgcn_readfirstlane(tid >> 6);
    const int gw = blockIdx.x * 8 + w, NGW = gridDim.x * 8;
    for (int r0 = gw * 4; r0 < MREAL; r0 += NGW * 4) {
        f32x4 v[4][4];
#pragma unroll
        for (int rr = 0; rr < 4; ++rr) { const int row = r0 + rr;
            const float* xr = (row < MP ? srcp + (size_t)row * DM : srcs + (size_t)(row - MP) * DM) + 4 * lane;
#pragma unroll
            for (int j = 0; j < 4; ++j) v[rr][j] = *(const f32x4*)(xr + 256 * j); }
#pragma unroll
        for (int rr = 0; rr < 4; ++rr) { const int row = r0 + rr;
            if (do_ln) {
                float s = 0.f;
#pragma unroll
                for (int j = 0; j < 4; ++j) s += (v[rr][j][0] + v[rr][j][1]) + (v[rr][j][2] + v[rr][j][3]);
                const float mean = wave_sum(s) * (1.f / DM); float s2 = 0.f;
#pragma unroll
                for (int j = 0; j < 4; ++j) { v[rr][j] = v[rr][j] - mean; s2 += (v[rr][j][0] * v[rr][j][0] + v[rr][j][1] * v[rr][j][1]) + (v[rr][j][2] * v[rr][j][2] + v[rr][j][3] * v[rr][j][3]); }
                const float rstd = 1.f / sqrtf(wave_sum(s2) * (1.f / DM) + LN_EPS);
#pragma unroll
                for (int j = 0; j < 4; ++j) { const f32x4 gg = *(const f32x4*)(lg + 4 * lane + 256 * j), bb = *(const f32x4*)(lb + 4 * lane + 256 * j); v[rr][j] = v[rr][j] * rstd * gg + bb; }
            }
            if (xout) {
                float* xo = xout + (size_t)row * DM + 4 * lane;
#pragma unroll
                for (int j = 0; j < 4; ++j) *(f32x4*)(xo + 256 * j) = v[rr][j];
            }
            const int ar = ada_row(row);
            if (H) {
                const float* shp = ada_l + (size_t)ar * 6144 + sh_chunk * 1024 + 4 * lane; const float* scp = ada_l + (size_t)ar * 6144 + sc_chunk * 1024 + 4 * lane;
                bf16_t* ho = H + (size_t)row * DM + 4 * lane;
#pragma unroll
                for (int j = 0; j < 4; ++j) { const f32x4 sh = *(const f32x4*)(shp + 256 * j), sc = *(const f32x4*)(scp + 256 * j); const f32x4 h = v[rr][j] * (sc + 1.0f) + sh;
                    u32x2 w2; w2.x = cvt_pk_bf16(h[0], h[1]); w2.y = cvt_pk_bf16(h[2], h[3]); *(u32x2*)(ho + 256 * j) = w2; }
            }
            if (H2) {
                const float* shp = adakv + (size_t)ar * 2048 + 4 * lane; const float* scp = shp + 1024;
                bf16_t* ho = H2 + (size_t)row * DM + 4 * lane;
#pragma unroll
                for (int j = 0; j < 4; ++j) { const f32x4 sh = *(const f32x4*)(shp + 256 * j), sc = *(const f32x4*)(scp + 256 * j); const f32x4 h = v[rr][j] * (sc + 1.0f) + sh;
                    u32x2 w2; w2.x = cvt_pk_bf16(h[0], h[1]); w2.y = cvt_pk_bf16(h[2], h[3]); *(u32x2*)(ho + 256 * j) = w2; }
            }
        }
    }
}

__device__ __forceinline__ int t5_bucket(int rel) {
    const int n = rel < 0 ? -rel : rel; const int base = rel > 0 ? 16 : 0;
    if (n < 8) return base + n;
    int lg = (31 - __builtin_clz((unsigned)(n * n))) - 6 + 8; if (lg > 15) lg = 15;
    return base + lg;
}
constexpr int KS_STRIDE = 72, VT_STRIDE = 68, TAB_STRIDE = 264;
constexpr int LDS_KS = 0, LDS_VT = 2 * 64 * KS_STRIDE * 2, LDS_TAB = LDS_VT + 2 * 64 * VT_STRIDE * 2, LDS_SC = LDS_TAB + 16 * TAB_STRIDE * 4;
static_assert(LDS_SC + 8 * 544 * 4 <= 131072, "attn lds");

template <int MODE> __device__ __forceinline__ void attn_build_tab(unsigned char* lds, const float* src) {
    const int tid = opaque_tid();
    float* tab = (float*)(lds + LDS_TAB);
    if (MODE == 0) { for (int idx = tid; idx < 16 * 256; idx += 512) { const int h = idx >> 8, i = idx & 255; tab[h * TAB_STRIDE + i] = src[t5_bucket(i - 191) * 16 + h] * LOG2E; } }
    else { for (int idx = tid; idx < 16 * 257; idx += 512) { const int h = idx / 257, i = idx - h * 257; tab[h * TAB_STRIDE + i] = src[idx] * LOG2E; } }
    __syncthreads();
}

template <int MODE> __device__ __forceinline__ void attn_chunk(const bf16_t* kb, const bf16_t* vb, const float* tabh, const bf16x8 (&qf)[2], f32x4 (&o)[4], float& mrun, float& lsum,
                                                               int j, int cw, int qpos, int l15, int quad) {
    f32x4 s[4];
#pragma unroll
    for (int t = 0; t < 4; ++t) { s[t] = (f32x4){0.f, 0.f, 0.f, 0.f};
#pragma unroll
        for (int kk = 0; kk < 2; ++kk) { const bf16x8 kf = *(const bf16x8*)(kb + (16 * t + l15) * KS_STRIDE + kk * 32 + quad * 8); s[t] = __builtin_amdgcn_mfma_f32_16x16x32_bf16(kf, qf[kk], s[t], 0, 0, 0); } }
    float mx = -1e30f;
    if (MODE == 1 && cw - j >= 3) {
        const float bc = tabh[256];
#pragma unroll
        for (int t = 0; t < 4; ++t) { s[t] = s[t] * SCALE2 + bc; mx = fmaxf(mx, fmaxf(fmaxf(s[t][0], s[t][1]), fmaxf(s[t][2], s[t][3]))); }
    } else {
#pragma unroll
        for (int t = 0; t < 4; ++t)
#pragma unroll
            for (int jj = 0; jj < 4; ++jj) { const int kpos = j * 64 + 16 * t + quad * 4 + jj; int idx;
                if (MODE == 0) idx = kpos - qpos + 191; else { int d = qpos - kpos; d = d < -128 ? -128 : (d > 128 ? 128 : d); idx = d + 128; }
                const float v = s[t][jj] * SCALE2 + tabh[idx]; s[t][jj] = v; mx = fmaxf(mx, v); }
    }
    mx = fmaxf(mx, __shfl_xor(mx, 16)); mx = fmaxf(mx, __shfl_xor(mx, 32));
    const float mnew = fmaxf(mrun, mx); const float alpha = __builtin_amdgcn_exp2f(mrun - mnew); mrun = mnew;
    float ps = 0.f;
#pragma unroll
    for (int t = 0; t < 4; ++t)
#pragma unroll
        for (int jj = 0; jj < 4; ++jj) { const float p = __builtin_amdgcn_exp2f(s[t][jj] - mnew); s[t][jj] = p; ps += p; }
    lsum = lsum * alpha + ps;
#pragma unroll
    for (int dt = 0; dt < 4; ++dt) o[dt] = o[dt] * alpha;
#pragma unroll
    for (int kb2 = 0; kb2 < 2; ++kb2) {
        u32x4 pw; pw.x = cvt_pk_bf16(s[2 * kb2][0], s[2 * kb2][1]); pw.y = cvt_pk_bf16(s[2 * kb2][2], s[2 * kb2][3]); pw.z = cvt_pk_bf16(s[2 * kb2 + 1][0], s[2 * kb2 + 1][1]); pw.w = cvt_pk_bf16(s[2 * kb2 + 1][2], s[2 * kb2 + 1][3]);
        const bf16x8 pf = __builtin_bit_cast(bf16x8, pw);
#pragma unroll
        for (int dt = 0; dt < 4; ++dt) { const bf16_t* vp = vb + (16 * dt + l15) * VT_STRIDE + 32 * kb2 + quad * 4;
            const u32x2 lo = *(const u32x2*)vp, hi = *(const u32x2*)(vp + 16); u32x4 vw; vw.x = lo.x; vw.y = lo.y; vw.z = hi.x; vw.w = hi.y;
            o[dt] = __builtin_amdgcn_mfma_f32_16x16x32_bf16(__builtin_bit_cast(bf16x8, vw), pf, o[dt], 0, 0, 0); }
    }
}


template <int MODE> __device__ __forceinline__ void attn_unit_dec(int t, int G, int& b, int& hx, int& cx) {
    if (G == 256) { const int k = blockIdx.x, x = k & 7, i = k >> 3;
        if (MODE == 0) { const int hp = i & 1, r = (i >> 1) & 3, st = x * 4 + (i >> 3); b = st >> 2; hx = (st & 3) * 2 + hp; cx = 4 * t + r; }
        else { const int h = i & 1, st = x * 16 + (i >> 1); b = st >> 4; hx = st & 15; cx = 2 * t + h; }
    } else { const int u = blockIdx.x + t * G;
        if (MODE == 0) { hx = u & 7; cx = (u >> 3) & 127; b = u >> 10; } else { hx = u & 15; cx = (u >> 4) & 63; b = u >> 10; } }
}
template <int MODE> __device__ __forceinline__ void attn_prompt(unsigned char* lds, const bf16_t* Q, const bf16_t* KV, bf16_t* O, const float* sinks) {
    const int tid = opaque_tid(), lane = tid & 63, w = __builtin_amdgcn_readfirstlane(tid >> 6);
    constexpr int NBACK = MODE == 0 ? 2 : 8;
    constexpr int LDQ = MODE == 0 ? 1536 : 1024, LDKV = MODE == 0 ? 1536 : 2048;
    bf16_t* Ks = (bf16_t*)(lds + LDS_KS); bf16_t* Vt = (bf16_t*)(lds + LDS_VT); const float* tab = (const float*)(lds + LDS_TAB);
    const int l15 = lane & 15, quad = lane >> 4;
    const int skey = tid >> 3, spart = tid & 7;
    const int G = gridDim.x;
    const int NU = (G == 256) ? 32 : (8192 - (int)blockIdx.x + G - 1) / G;
    int lt = 0, lj = 0, ljhi = 0; const bf16_t* lkb = KV; const bf16_t* lvb = KV;
#define AT_LC_SETUP() do { if (lt < NU) { int b_, hx_, cx_; attn_unit_dec<MODE>(lt, G, b_, hx_, cx_); \
        if (MODE == 0) { lj = cx_ - 2 < 0 ? 0 : cx_ - 2; ljhi = cx_; lkb = KV + (size_t)b_ * SEQ * LDKV + 1024 + (hx_ >> 1) * 64; lvb = lkb + 256; } \
        else { lj = 2 * cx_ - 8 < 0 ? 0 : 2 * cx_ - 8; ljhi = 2 * cx_ + 1; lkb = KV + (size_t)b_ * SEQ * LDKV + hx_ * 64; lvb = lkb + 1024; } } } while (0)
#define AT_LC_LOAD(KR, VR) do { if (lt < NU) { KR = *(const u32x4*)(lkb + (size_t)(lj * 64 + skey) * LDKV + spart * 8); VR = *(const u32x4*)(lvb + (size_t)(lj * 64 + skey) * LDKV + spart * 8); \
        if (++lj > ljhi) { ++lt; AT_LC_SETUP(); } } } while (0)
    int ct = 0, cj = 0, cjlo = 0, cjhi = 0, head = 0, cw = 0, qpos = 0; size_t qrow = 0;
    bf16x8 qf[2], qn[2];
    f32x4 o[4]; float mrun = 0.f, lsum = 0.f;
#define AT_QLOAD(T) do { if ((T) < NU) { int b_, hx_, cx_; attn_unit_dec<MODE>((T), G, b_, hx_, cx_); \
        const int hd_ = MODE == 0 ? (hx_ >> 1) * 4 + (hx_ & 1) * 2 + (w >> 2) : hx_; const int cw_ = MODE == 0 ? cx_ : 2 * cx_ + (w >> 2); \
        const size_t qr_ = (size_t)b_ * SEQ + cw_ * 64 + (w & 3) * 16 + l15; \
        qn[0] = *(const bf16x8*)(Q + qr_ * LDQ + hd_ * 64 + quad * 8); qn[1] = *(const bf16x8*)(Q + qr_ * LDQ + hd_ * 64 + 32 + quad * 8); } } while (0)
#define AT_CC_SETUP() do { if (ct < NU) { int b_, hx_, cx_; attn_unit_dec<MODE>(ct, G, b_, hx_, cx_); \
        if (MODE == 0) { cjlo = cx_ - 2 < 0 ? 0 : cx_ - 2; cjhi = cx_; head = (hx_ >> 1) * 4 + (hx_ & 1) * 2 + (w >> 2); cw = cx_; } \
        else { cjlo = 2 * cx_ - 8 < 0 ? 0 : 2 * cx_ - 8; cjhi = 2 * cx_ + 1; head = hx_; cw = 2 * cx_ + (w >> 2); } \
        cj = cjlo; qpos = cw * 64 + (w & 3) * 16 + l15; qrow = (size_t)b_ * SEQ + qpos; } } while (0)
    u32x4 kr0, vr0, kr1, vr1;
    kr0 = vr0 = kr1 = vr1 = (u32x4){0u, 0u, 0u, 0u};
    AT_LC_SETUP(); AT_LC_LOAD(kr0, vr0); AT_LC_LOAD(kr1, vr1);
    AT_QLOAD(0); AT_CC_SETUP();
#define AT_STEP(KR, VR, BUF) do { \
        { bf16_t* kd = Ks + (BUF) * 64 * KS_STRIDE + skey * KS_STRIDE + spart * 8; *(u32x4*)kd = KR; \
          bf16_t* vd = Vt + (BUF) * 64 * VT_STRIDE + (spart * 8) * VT_STRIDE + skey; \
          vd[0 * VT_STRIDE] = (bf16_t)(VR.x & 0xffff); vd[1 * VT_STRIDE] = (bf16_t)(VR.x >> 16); vd[2 * VT_STRIDE] = (bf16_t)(VR.y & 0xffff); vd[3 * VT_STRIDE] = (bf16_t)(VR.y >> 16); \
          vd[4 * VT_STRIDE] = (bf16_t)(VR.z & 0xffff); vd[5 * VT_STRIDE] = (bf16_t)(VR.z >> 16); vd[6 * VT_STRIDE] = (bf16_t)(VR.w & 0xffff); vd[7 * VT_STRIDE] = (bf16_t)(VR.w >> 16); } \
        AT_LC_LOAD(KR, VR); \
        asm volatile("s_waitcnt lgkmcnt(0)" ::: "memory"); __builtin_amdgcn_s_barrier(); asm volatile("" ::: "memory"); \
        if (cj == cjlo) { qf[0] = qn[0]; qf[1] = qn[1]; AT_QLOAD(ct + 1); \
            _Pragma("unroll") for (int dt = 0; dt < 4; ++dt) o[dt] = (f32x4){0.f, 0.f, 0.f, 0.f}; \
            if (MODE == 0) { mrun = sinks[head] * LOG2E; lsum = quad == 0 ? 1.0f : 0.0f; } else { mrun = -1e30f; lsum = 0.f; } } \
        if (cj >= cw - NBACK && cj <= cw) attn_chunk<MODE>(Ks + (BUF) * 64 * KS_STRIDE, Vt + (BUF) * 64 * VT_STRIDE, tab + head * TAB_STRIDE, qf, o, mrun, lsum, cj, cw, qpos, l15, quad); \
        if (cj == cjhi) { float ls_ = lsum; ls_ += __shfl_xor(ls_, 16); ls_ += __shfl_xor(ls_, 32); const float inv_ = 1.0f / ls_; \
            bf16_t* op_ = O + qrow * DM + head * 64 + quad * 4; \
            _Pragma("unroll") for (int dt = 0; dt < 4; ++dt) { u32x2 w2; w2.x = cvt_pk_bf16(o[dt][0] * inv_, o[dt][1] * inv_); w2.y = cvt_pk_bf16(o[dt][2] * inv_, o[dt][3] * inv_); *(u32x2*)(op_ + 16 * dt) = w2; } \
            ++ct; AT_CC_SETUP(); } else ++cj; \
    } while (0)
    while (ct < NU) {
        AT_STEP(kr0, vr0, 0);
        if (ct >= NU) break;
        AT_STEP(kr1, vr1, 1);
    }
    __syncthreads();
#undef AT_LC_SETUP
#undef AT_LC_LOAD
#undef AT_QLOAD
#undef AT_CC_SETUP
#undef AT_STEP
}


template <int MODE> __device__ __forceinline__ void attn_sample(unsigned char* lds, const bf16_t* Q, const bf16_t* KV, bf16_t* O, const float* ck_all, const float* cv_all,
                                                                const float* tabsrc, const float* sinks) {
    const int tid = opaque_tid(), lane = tid & 63, w = __builtin_amdgcn_readfirstlane(tid >> 6);
    constexpr int P = MODE == 0 ? 128 : 512, NK = P + 16;
    constexpr int LDQ = MODE == 0 ? 1536 : 1024, LDKV = MODE == 0 ? 1536 : 2048, CST = MODE == 0 ? 256 : 1024;
    float* sc = (float*)(lds + LDS_SC) + w * 544;
    const int kq = lane >> 4, dl = lane & 15;
    for (int task = blockIdx.x * 8 + w; task < 2048; task += gridDim.x * 8) {
        const int i = task & 15, head = (task >> 4) & 15, b = task >> 8;
        const size_t srow = (size_t)MP + b * 16 + i;
        const float* ck; const float* cv; const bf16_t* nk; const bf16_t* nv;
        if (MODE == 0) { const int kvh = head >> 2; ck = ck_all + ((size_t)b * 128 * 4 + kvh) * 64; cv = cv_all + ((size_t)b * 128 * 4 + kvh) * 64; nk = KV + ((size_t)MP + b * 16) * LDKV + 1024 + kvh * 64; nv = nk + 256; }
        else { ck = ck_all + ((size_t)b * 512 * 16 + head) * 64; cv = cv_all + ((size_t)b * 512 * 16 + head) * 64; nk = KV + ((size_t)MP + b * 16) * LDKV + head * 64; nv = nk + 1024; }
        f32x4 q4; { const u32x2 qw = *(const u32x2*)(Q + srow * LDQ + head * 64 + 4 * dl); q4[0] = bf2f(qw.x & 0xffff); q4[1] = bf2f(qw.x >> 16); q4[2] = bf2f(qw.y & 0xffff); q4[3] = bf2f(qw.y >> 16); }
        for (int g = 0; g < NK / 4; ++g) {
            const int key = 4 * g + kq; f32x4 k4;
            if (key < P) k4 = *(const f32x4*)(ck + (size_t)key * CST + 4 * dl);
            else { const u32x2 kw = *(const u32x2*)(nk + (size_t)(key - P) * LDKV + 4 * dl); k4[0] = bf2f(kw.x & 0xffff); k4[1] = bf2f(kw.x >> 16); k4[2] = bf2f(kw.y & 0xffff); k4[3] = bf2f(kw.y >> 16); }
            float part = (q4[0] * k4[0] + q4[1] * k4[1]) + (q4[2] * k4[2] + q4[3] * k4[3]);
            part += __shfl_xor(part, 1); part += __shfl_xor(part, 2); part += __shfl_xor(part, 4); part += __shfl_xor(part, 8);
            if (dl == 0) { float bias;
                if (MODE == 0) bias = tabsrc[t5_bucket(key - 128 - i) * 16 + head];
                else { int d = (2048 + i) - (1536 + key); d = d < -128 ? -128 : (d > 128 ? 128 : d); bias = tabsrc[head * 257 + d + 128]; }
                sc[key] = part * 0.125f + bias; }
        }
        asm volatile("s_waitcnt lgkmcnt(0)" ::: "memory");
        float mx = MODE == 0 ? sinks[head] : -1e30f;
        for (int key = lane; key < NK; key += 64) mx = fmaxf(mx, sc[key]);
        mx = wave_max(mx);
        float sum = 0.f;
        for (int key = lane; key < NK; key += 64) { const float e = __expf(sc[key] - mx); sc[key] = e; sum += e; }
        sum = wave_sum(sum);
        if (MODE == 0) sum += __expf(sinks[head] - mx);
        asm volatile("s_waitcnt lgkmcnt(0)" ::: "memory");
        f32x4 acc = (f32x4){0.f, 0.f, 0.f, 0.f};
        for (int g = 0; g < NK / 4; ++g) {
            const int key = 4 * g + kq; f32x4 v4;
            if (key < P) v4 = *(const f32x4*)(cv + (size_t)key * CST + 4 * dl);
            else { const u32x2 kw = *(const u32x2*)(nv + (size_t)(key - P) * LDKV + 4 * dl); v4[0] = bf2f(kw.x & 0xffff); v4[1] = bf2f(kw.x >> 16); v4[2] = bf2f(kw.y & 0xffff); v4[3] = bf2f(kw.y >> 16); }
            acc = acc + v4 * sc[key];
        }
#pragma unroll
        for (int j = 0; j < 4; ++j) { acc[j] += __shfl_xor(acc[j], 16); acc[j] += __shfl_xor(acc[j], 32); }
        const float inv = 1.0f / sum;
        if (kq == 0) { u32x2 w2; w2.x = cvt_pk_bf16(acc[0] * inv, acc[1] * inv); w2.y = cvt_pk_bf16(acc[2] * inv, acc[3] * inv); *(u32x2*)(O + srow * DM + head * 64 + 4 * dl) = w2; }
        asm volatile("s_waitcnt lgkmcnt(0)" ::: "memory");
    }
}

__device__ __forceinline__ void conv_act4(const f32x4 (&ua)[3], const f32x4 (&ug)[3], const float* cw, const float* cb, int c, bf16_t* dst) {
    const f32x4 ya = *(const f32x4*)(cb + c) + *(const f32x4*)(cw + 2 * FF2 + c) * ua[0] + *(const f32x4*)(cw + FF2 + c) * ua[1] + *(const f32x4*)(cw + c) * ua[2];
    const f32x4 yg = *(const f32x4*)(cb + FF + c) + *(const f32x4*)(cw + 2 * FF2 + FF + c) * ug[0] + *(const f32x4*)(cw + FF2 + FF + c) * ug[1] + *(const f32x4*)(cw + FF + c) * ug[2];
    u32x2 w; w.x = cvt_pk_bf16(gelu_tanh(yg[0]) * ya[0], gelu_tanh(yg[1]) * ya[1]); w.y = cvt_pk_bf16(gelu_tanh(yg[2]) * ya[2], gelu_tanh(yg[3]) * ya[3]);
    *(u32x2*)dst = w;
}
__device__ __forceinline__ void fixup_phase(const Params& P, int l) {
    const int tid = opaque_tid();
    const float* UH = (const float*)(P.ws + WS_UH); const float* US = (const float*)(P.ws + WS_USAMP); bf16_t* ACT = (bf16_t*)(P.ws + WS_ACT);
    const float* cw = P.in[24] + (size_t)l * 3 * FF2; const float* cb = P.in[25] + (size_t)l * FF2;
    const float* st = P.in[8] + (size_t)l * 8 * 2 * FF2; float* cvs = P.out + O_CVS + (size_t)l * 8 * 2 * FF2;
    const int gt = blockIdx.x * 512 + tid, NT = gridDim.x * 512;
    const f32x4 z = (f32x4){0.f, 0.f, 0.f, 0.f};
    for (int idx = gt; idx < 1024 * 2 * 704; idx += NT) {
        const int cq = idx % 704, rr = (idx / 704) & 1, g = idx / 1408, c = 4 * cq;
        const bool first = (g & 127) == 0;
        const float* r0 = UH + ((size_t)g * 4 + rr) * FF2;
        const float* r1 = rr == 0 ? UH + ((size_t)(g - 1) * 4 + 3) * FF2 : UH + ((size_t)g * 4 + 0) * FF2;
        const float* r2 = rr == 0 ? UH + ((size_t)(g - 1) * 4 + 2) * FF2 : UH + ((size_t)(g - 1) * 4 + 3) * FF2;
        f32x4 ua[3], ug[3];
        ua[0] = *(const f32x4*)(r0 + c); ug[0] = *(const f32x4*)(r0 + FF + c);
        if (rr == 0 && first) { ua[1] = z; ug[1] = z; } else { ua[1] = *(const f32x4*)(r1 + c); ug[1] = *(const f32x4*)(r1 + FF + c); }
        if (first) { ua[2] = z; ug[2] = z; } else { ua[2] = *(const f32x4*)(r2 + c); ug[2] = *(const f32x4*)(r2 + FF + c); }
        conv_act4(ua, ug, cw, cb, c, ACT + (size_t)(g * 64 + rr) * FF + c);
    }
    for (int idx = gt; idx < 128 * 704; idx += NT) {
        const int cq = idx % 704, s = idx / 704, c = 4 * cq, b = s >> 4, t = s & 15;
        const float* r0 = US + (size_t)s * FF2;
        const float* r1 = t >= 1 ? US + (size_t)(s - 1) * FF2 : st + (size_t)(b * 2 + 1) * FF2;
        const float* r2 = t >= 2 ? US + (size_t)(s - 2) * FF2 : st + (size_t)(b * 2 + t) * FF2;
        f32x4 ua[3], ug[3];
        ua[0] = *(const f32x4*)(r0 + c); ug[0] = *(const f32x4*)(r0 + FF + c);
        ua[1] = *(const f32x4*)(r1 + c); ug[1] = *(const f32x4*)(r1 + FF + c);
        ua[2] = *(const f32x4*)(r2 + c); ug[2] = *(const f32x4*)(r2 + FF + c);
        conv_act4(ua, ug, cw, cb, c, ACT + (size_t)(MP + s) * FF + c);
        if (t >= 14) { float* d = cvs + (size_t)(b * 2 + (t - 14)) * FF2; *(f32x4*)(d + c) = ua[0]; *(f32x4*)(d + FF + c) = ug[0]; }
    }
}

#ifndef PROBE_MASK
#define PROBE_MASK 0
#endif
#define PB(bit) do { if ((PROBE_MASK) & (bit)) { if (blockIdx.x == 0 && threadIdx.x == 0) ((volatile unsigned*)(lds + 140000))[1] = (unsigned)__builtin_amdgcn_s_memrealtime(); } } while (0)
#define PE(bit) do { if ((PROBE_MASK) & (bit)) { if (blockIdx.x == 0 && threadIdx.x == 0) { volatile unsigned* pw = (volatile unsigned*)(lds + 140000); pw[0] = pw[0] + ((unsigned)__builtin_amdgcn_s_memrealtime() - pw[1]); } } } while (0)
__global__ void __launch_bounds__(512, 2) yoco_fwd(Params P) {
    extern __shared__ __attribute__((aligned(16))) unsigned char lds[];
    cg::grid_group grid = cg::this_grid();
    unsigned char* ws = P.ws;
    float* out = P.out;
    const float* ada = (const float*)(ws + WS_ADA); const float* adakv = (const float*)(ws + WS_ADAKV);
    bf16_t* H = (bf16_t*)(ws + WS_H); bf16_t* HKV = (bf16_t*)(ws + WS_HKV); bf16_t* QKV = (bf16_t*)(ws + WS_QKV); bf16_t* OB = (bf16_t*)(ws + WS_O);
    bf16_t* KVB = (bf16_t*)(ws + WS_KVB); bf16_t* ACT = (bf16_t*)(ws + WS_ACT);

    if (PROBE_MASK) { if (blockIdx.x == 0 && threadIdx.x == 0) ((volatile unsigned*)(lds + 140000))[0] = 0u; }
    PB(1);
    p0_ada(lds, P);
    __syncthreads();
    p0_weights(lds, P);
    grid.sync();
    row_pass(P.in[0], P.in[1], false, nullptr, nullptr, nullptr, ada, 0, 1, H, nullptr, nullptr);
    grid.sync();
    PE(1);

    for (int sl = 0; sl < 8; ++sl) {
        const int l = sl >> 1; const bool ffn = sl & 1;
        const float* ada_l = ada + (size_t)l * 16 * 6144;
        pg8::Gemm gres;
        if (!ffn) {
            PB(2);
            const int npass = (l == 2) ? 2 : 1;
            for (int pass = 0; pass < npass; ++pass) {
                pg8::Gemm g; EpiProj E;
                if (l == 2 && pass == 0) {
                    g = pg8::Gemm{HKV, (const bf16_t*)(ws + WS_WKV), MR, 2048, 1024};
                    E = EpiProj{KVB, 2048, Extra{out + O_BKP, out + O_BKS, 0, 1024, 512}, Extra{out + O_BVP, out + O_BVS, 1024, 1024, 512}};
                } else if (l < 2) {
                    g = pg8::Gemm{H, (const bf16_t*)(ws + WS_WQKV) + (size_t)l * 1536 * 1024, MR, 1536, 1024};
                    E = EpiProj{QKV, 1536, Extra{out + O_AKP + (size_t)l * 8 * 128 * 256, out + O_AKS + (size_t)l * 128 * 256, 1024, 256, 128},
                                Extra{out + O_AVP + (size_t)l * 8 * 128 * 256, out + O_AVS + (size_t)l * 128 * 256, 1280, 256, 128}};
                } else {
                    g = pg8::Gemm{H, (const bf16_t*)(ws + WS_WQB) + (size_t)(l - 2) * 1024 * 1024, MR, 1024, 1024};
                    E = EpiProj{QKV, 1024, Extra{nullptr, nullptr, 0, 0, 0}, Extra{nullptr, nullptr, 0, 0, 0}};
                }
                pg8::StaticOrder S; S.init(g.M, g.N, gridDim.x, blockIdx.x);
                pg8::gemm_phase<EpiProj, pg8::StaticOrder>((LAS unsigned char*)lds, g, S, E);
            }
            grid.sync();
            PE(2);
            PB(4);
            if (l < 2) {
                attn_sample<0>(lds, QKV, QKV, OB, P.in[4] + (size_t)l * 8 * 128 * 256, P.in[5] + (size_t)l * 8 * 128 * 256, P.in[16], P.in[15] + l * 16);
                attn_build_tab<0>(lds, P.in[16]);
                attn_prompt<0>(lds, QKV, QKV, OB, P.in[15] + l * 16);
            } else {
                attn_sample<1>(lds, QKV, KVB, OB, P.in[6], P.in[7], P.in[22] + (size_t)(l - 2) * 16 * 257, nullptr);
                attn_build_tab<1>(lds, P.in[22] + (size_t)(l - 2) * 16 * 257);
                attn_prompt<1>(lds, QKV, KVB, OB, nullptr);
            }
            grid.sync();
            PE(4);
            gres = pg8::Gemm{OB, l < 2 ? (const bf16_t*)(ws + WS_WOA) + (size_t)l * 1024 * 1024 : (const bf16_t*)(ws + WS_WOB) + (size_t)(l - 2) * 1024 * 1024, MR, 1024, 1024};
        } else {
            PB(32);
            {
                pg8::Gemm g{H, (const bf16_t*)(ws + WS_WUP) + (size_t)l * FF2 * 1024, MR, FF2, 1024};
                EpiUp E{ACT, (float*)(ws + WS_UH), (float*)(ws + WS_USAMP), P.in[24] + (size_t)l * 3 * FF2, P.in[25] + (size_t)l * FF2, out + O_CVP + (size_t)l * 8 * 2 * FF2};
                pg8::StaticOrder S; S.init(g.M, g.N, gridDim.x, blockIdx.x);
                pg8::gemm_phase<EpiUp, pg8::StaticOrder>((LAS unsigned char*)lds, g, S, E);
            }
            grid.sync();
            PE(32);
            PB(64);
            fixup_phase(P, l);
            grid.sync();
            PE(64);
            gres = pg8::Gemm{ACT, (const bf16_t*)(ws + WS_WDN) + (size_t)l * 1024 * FF, MR, 1024, FF};
        }
        PB(8);
        {
            const bool first = (sl == 0);
            EpiRes E{first ? P.in[0] : out, first ? P.in[1] : out + (size_t)MP * DM, out, ada_l + (ffn ? 5 : 2) * 1024};
            pg8::StaticOrder S; S.init(gres.M, gres.N, gridDim.x, blockIdx.x);
            pg8::gemm_phase<EpiRes, pg8::StaticOrder>((LAS unsigned char*)lds, gres, S, E);
        }
        grid.sync();
        PE(8);
        PB(16);
        {
            const float* lg = P.in[11] + (size_t)(l * 2 + (ffn ? 1 : 0)) * DM; const float* lb = P.in[12] + (size_t)(l * 2 + (ffn ? 1 : 0)) * DM;
            if (!ffn) row_pass(out, out + (size_t)MP * DM, true, lg, lb, out, ada_l, 3, 4, H, nullptr, nullptr);
            else if (l < 3) row_pass(out, out + (size_t)MP * DM, true, lg, lb, out, ada_l + 16 * 6144, 0, 1, H, l == 1 ? adakv : nullptr, l == 1 ? HKV : nullptr);
            else row_pass(out, out + (size_t)MP * DM, true, lg, lb, out, nullptr, 0, 0, nullptr, nullptr, nullptr);
        }
        if (sl < 7) grid.sync();
        PE(16);
    }
    if (PROBE_MASK) { if (blockIdx.x == 0 && threadIdx.x == 0) { const unsigned t0 = (unsigned)__builtin_amdgcn_s_memrealtime(); const unsigned wait = ((volatile unsigned*)(lds + 140000))[0];
        while ((unsigned)__builtin_amdgcn_s_memrealtime() - t0 < wait) __builtin_amdgcn_s_sleep(8); } }
}

extern "C" void kernel_launch(void* const* d_in, const int* in_sizes, int n_in, void* d_out, int out_size, void* d_ws, size_t ws_size, hipStream_t stream) {
    static int grid = 0;
    if (grid == 0) {
        if (n_in != 27 || (size_t)out_size != O_END || ws_size < WS_END) { fprintf(stderr, "kernel_launch: unexpected shapes: n_in %d out %d (want %zu) ws %zu (need %zu)\n", n_in, out_size, (size_t)O_END, ws_size, (size_t)WS_END); grid = -1; return; }
        int dev = 0, cus = 0, per_cu = 0;
        (void)hipGetDevice(&dev);
        (void)hipDeviceGetAttribute(&cus, hipDeviceAttributeMultiprocessorCount, dev);
        if (hipFuncSetAttribute((const void*)yoco_fwd, hipFuncAttributeMaxDynamicSharedMemorySize, LDS_BYTES) != hipSuccess) { fprintf(stderr, "kernel_launch: hipFuncSetAttribute failed\n"); grid = -1; return; }
        if (hipOccupancyMaxActiveBlocksPerMultiprocessor(&per_cu, (const void*)yoco_fwd, 512, LDS_BYTES) != hipSuccess || per_cu < 1) { fprintf(stderr, "kernel_launch: occupancy query says %d\n", per_cu); per_cu = 1; }
        (void)hipGetLastError();
        grid = cus;
    }
    if (grid < 0) return;
    Params p{};
    for (int i = 0; i < 27; ++i) p.in[i] = (const float*)d_in[i];
    p.out = (float*)d_out; p.ws = (unsigned char*)d_ws;
    void* args[] = {&p};
    hipError_t e = hipLaunchCooperativeKernel((const void*)yoco_fwd, dim3(grid), dim3(512), args, LDS_BYTES, stream);
    if (e != hipSuccess) fprintf(stderr, "kernel_launch: cooperative launch failed: %s (grid %d)\n", hipGetErrorString(e), grid);
}
```

```cpp
#include <hip/hip_runtime.h>
#include <hip/hip_cooperative_groups.h>
#include <cstdio>
#include <cstdint>
namespace cg = cooperative_groups;

#define LAS __attribute__((address_space(3)))
typedef unsigned short bf16_t;
typedef short bf16x8 __attribute__((ext_vector_type(8)));
typedef float f32x4 __attribute__((ext_vector_type(4)));
typedef unsigned u32x4 __attribute__((ext_vector_type(4)));
typedef unsigned u32x2 __attribute__((ext_vector_type(2)));

constexpr int DM = 1024, SEQ = 8192, NBATCH = 8, MP = NBATCH * SEQ, MS = 128, MREAL = MP + MS, MR = 65792;
constexpr int FF = 2816, FF2 = 5632;
constexpr float ALPHA = 1.681792830507429f;
constexpr float LN_EPS = 1e-5f;
constexpr float LOG2E = 1.4426950408889634f;
constexpr float SCALE2 = 0.125f * LOG2E;

constexpr size_t O_Y = 0;
constexpr size_t O_AKP = (size_t)MREAL * DM;
constexpr size_t O_AVP = O_AKP + 2 * 8 * 128 * 256;
constexpr size_t O_BKP = O_AVP + 2 * 8 * 128 * 256;
constexpr size_t O_BVP = O_BKP + (size_t)8 * 512 * 1024;
constexpr size_t O_CVP = O_BVP + (size_t)8 * 512 * 1024;
constexpr size_t O_AKS = O_CVP + 4 * 8 * 2 * FF2;
constexpr size_t O_AVS = O_AKS + 2 * 128 * 256;
constexpr size_t O_BKS = O_AVS + 2 * 128 * 256;
constexpr size_t O_BVS = O_BKS + 128 * 1024;
constexpr size_t O_CVS = O_BVS + 128 * 1024;
constexpr size_t O_END = O_CVS + 4 * 8 * 2 * FF2;

constexpr size_t MiB = 1u << 20;
constexpr size_t WS_WQKV = 1 * MiB, WS_WOA = 7 * MiB, WS_WKV = 11 * MiB, WS_WQB = 15 * MiB, WS_WOB = 19 * MiB, WS_WUP = 23 * MiB, WS_WDN = 67 * MiB;
constexpr size_t WS_ADA = 89 * MiB, WS_ADAKV = 90 * MiB + 512 * 1024, WS_USAMP = 91 * MiB, WS_UH = 94 * MiB;
constexpr size_t WS_H = 183 * MiB, WS_KVB = 312 * MiB, WS_R = 569 * MiB;
constexpr size_t WS_QKV = WS_R, WS_O = WS_R + 193 * MiB, WS_HKV = WS_R + 224 * MiB, WS_ACT = WS_R, WS_END = 923 * MiB;
static_assert(WS_UH + (size_t)1024 * 4 * FF2 * 4 <= WS_H, "uh");
static_assert(WS_H + (size_t)MR * DM * 2 <= WS_KVB, "h");
static_assert(WS_KVB + (size_t)MR * 2048 * 2 <= WS_R, "kvb");
static_assert(WS_ACT + (size_t)MR * FF * 2 <= WS_END && WS_HKV + (size_t)MR * DM * 2 <= WS_END && WS_QKV + (size_t)MR * 1536 * 2 <= WS_O && WS_O + (size_t)MR * DM * 2 <= WS_END, "r");

constexpr int LDS_BYTES = 147456;

struct Params { const float* in[27]; float* out; unsigned char* ws; };

__device__ __forceinline__ int opaque_tid() { int t = threadIdx.x; asm volatile("" : "+v"(t)); return t; }
__device__ __forceinline__ unsigned cvt_pk_bf16(float lo, float hi) { unsigned r; asm volatile("v_cvt_pk_bf16_f32 %0, %1, %2" : "=v"(r) : "v"(lo), "v"(hi)); return r; }
__device__ __forceinline__ float bf2f(unsigned short h) { return __builtin_bit_cast(float, (unsigned)h << 16); }
__device__ __forceinline__ int ada_row(int row) { int r = row < MP ? (row >> 13) : 8 + ((row - MP) >> 4); return r > 15 ? 15 : r; }
__device__ __forceinline__ float gelu_tanh(float x) {
    const float z = 0.7978845608028654f * (x + 0.044715f * x * x * x);
    const float t = __builtin_amdgcn_exp2f(z * (2.0f * LOG2E));
    return x - x * __builtin_amdgcn_rcpf(1.0f + t);
}
__device__ __forceinline__ float wave_sum(float v) {
#pragma unroll
    for (int o = 1; o < 64; o <<= 1) v += __shfl_xor(v, o);
    return v;
}
__device__ __forceinline__ float wave_max(float v) {
#pragma unroll
    for (int o = 1; o < 64; o <<= 1) v = fmaxf(v, __shfl_xor(v, o));
    return v;
}

namespace pg8 {
constexpr int BM = 256, BK = 64, HALF = 128, HTB = HALF * BK * 2, STAGE_BYTES = 8 * HTB, NXCD = 8, WGM = 8;
__host__ __device__ __forceinline__ int lds_byte(int r, int c) { const int st = (r >> 4) * 2 + (c >> 5), rr = r & 15, cc = c & 31, ob = rr * 64 + cc * 2; return st * 1024 + (ob ^ (((ob >> 9) & 1) << 5)); }
__host__ __device__ __forceinline__ void stage_rc(int b, int& R, int& C) { const int st = b / 1024, sb = b % 1024, swz = sb ^ (((sb >> 9) & 1) << 5); R = (st >> 1) * 16 + swz / 64; C = (st & 1) * 32 + (swz % 64) / 2; }
__host__ __device__ __forceinline__ int perm32(int rho) { const int n = rho >> 4, i = rho & 15; return 8 * (i >> 2) + 4 * n + (i & 3); }

struct Unit { int pm, pn; };
struct Gemm { const bf16_t* A; const bf16_t* Bt; int M, N, K; };

struct StaticOrder {
    int nM, nN, nwg, G, c;
    __device__ void init(int M, int N, int G_, int c_) { nM = M / BM; nN = N / BM; nwg = nM * nN; G = G_; c = c_; }
    __device__ bool next(int i, Unit& u) const {
        const long L = (long)i * G + c; if (L >= nwg) return false;
        int wgid = (int)L; { const int q = nwg / NXCD, r = nwg % NXCD, xcd = wgid % NXCD, off = wgid / NXCD; wgid = (xcd < r ? xcd * (q + 1) : r * (q + 1) + (xcd - r) * q) + off; }
        const int nig = WGM * nN, gid = wgid / nig, fm = gid * WGM, gsz = (nM - fm) < WGM ? (nM - fm) : WGM;
        u.pm = fm + ((wgid % nig) % gsz); u.pn = (wgid % nig) / gsz; return true;
    }
};

template <class Epi, class Sched>
__device__ __forceinline__ void gemm_phase(LAS unsigned char* lds, const Gemm g, const Sched& S, const Epi& E) {
    const int tid = opaque_tid(), wid = __builtin_amdgcn_readfirstlane(tid >> 6), lane = tid & 63, wr = wid >> 2, wc = wid & 3, fr = lane & 15, fq = lane >> 4;
    const int K = g.K, nt = K / BK;
    unsigned voffA[2], voffB[2];
#pragma unroll
    for (int i = 0; i < 2; ++i) { int R, C; stage_rc(tid * 16 + i * 8192, R, C); const int Rb = Epi::PERM ? ((R & ~31) + perm32(R & 31)) : R;
        const int Ra = Epi::ROWPERM ? ((R & 64) | ((R & 15) << 2) | ((R >> 4) & 3)) : R;
        voffA[i] = (unsigned)(Ra * K + C) * 2u; voffB[i] = (unsigned)(Rb * K + C) * 2u; }
    const size_t kstep = (size_t)(BK * 2);
    const size_t hstep = (size_t)HALF * K * 2;
    const size_t tstep = 2 * hstep;
    const unsigned ldsw = (unsigned)wid * 1024u;
    const int aoff = lds_byte(wr * 64 + fr, fq * 8), boff = lds_byte(wc * 32 + fr, fq * 8);
#define PG8_SA(b, h) (((b) * 2 + (h)) * HTB)
#define PG8_SB(b, h) ((4 + (b) * 2 + (h)) * HTB)
#define PG8_STAGE(bufoff, gbase, voff) do { _Pragma("unroll") for (int _i = 0; _i < 2; ++_i) \
        __builtin_amdgcn_global_load_lds((const unsigned*)((const char*)(gbase) + (voff)[_i]), (LAS unsigned*)(lds + (bufoff) + ldsw + _i * 8192), 16, 0, 0); } while (0)
#define PG8_LDA(dst, b, h) do { _Pragma("unroll") for (int m = 0; m < 4; ++m) _Pragma("unroll") for (int k = 0; k < 2; ++k) dst[m][k] = *(const LAS bf16x8*)(lds + PG8_SA(b, h) + aoff + m * 2048 + k * 1024); } while (0)
#define PG8_LDB(dst, b, h) do { _Pragma("unroll") for (int n = 0; n < 2; ++n) _Pragma("unroll") for (int k = 0; k < 2; ++k) dst[n][k] = *(const LAS bf16x8*)(lds + PG8_SB(b, h) + boff + n * 2048 + k * 1024); } while (0)
#define PG8_MMA(ai, bj, At, Bt) do { __builtin_amdgcn_s_setprio(1); _Pragma("unroll") for (int m = 0; m < 4; ++m) _Pragma("unroll") for (int n = 0; n < 2; ++n) _Pragma("unroll") for (int k = 0; k < 2; ++k) \
        acc[ai][bj][m][n] = __builtin_amdgcn_mfma_f32_16x16x32_bf16(Bt[n][k], At[m][k], acc[ai][bj][m][n], 0, 0, 0); __builtin_amdgcn_s_setprio(0); } while (0)
#define PG8_WAIT_V(n) asm volatile("s_waitcnt vmcnt(" #n ")" ::: "memory")
#define PG8_WAIT_L(n) asm volatile("s_waitcnt lgkmcnt(" #n ")" ::: "memory")
#define PG8_BAR __builtin_amdgcn_s_barrier()
#define PG8_SCHED __builtin_amdgcn_sched_barrier(0)
    Unit cur, nxt; int ui = 0;
    if (!S.next(0, cur)) return;
    f32x4 acc[2][2][4][2];
#pragma unroll
    for (int a = 0; a < 2; ++a)
#pragma unroll
        for (int b = 0; b < 2; ++b)
#pragma unroll
            for (int m = 0; m < 4; ++m)
#pragma unroll
                for (int n = 0; n < 2; ++n) acc[a][b][m][n] = (f32x4){0.f, 0.f, 0.f, 0.f};
    bf16x8 At[4][2], B0[2][2], B1[2][2];
    const char* cA = (const char*)g.A + (size_t)cur.pm * tstep; const char* cB = (const char*)g.Bt + (size_t)cur.pn * tstep;
    PG8_STAGE(PG8_SB(0, 0), cB, voffB); PG8_STAGE(PG8_SB(0, 1), cB + hstep, voffB); PG8_STAGE(PG8_SA(0, 0), cA, voffA); PG8_STAGE(PG8_SA(0, 1), cA + hstep, voffA);
    if (wr == 1) PG8_BAR;
    PG8_WAIT_V(2); PG8_BAR;
    PG8_STAGE(PG8_SB(1, 0), cB + kstep, voffB); PG8_STAGE(PG8_SA(1, 0), cA + kstep, voffA); PG8_STAGE(PG8_SB(1, 1), cB + hstep + kstep, voffB);
    PG8_WAIT_V(6); PG8_BAR;
    for (;;) {
        const bool has_next = S.next(ui + 1, nxt);
        const char* nA = has_next ? (const char*)g.A + (size_t)nxt.pm * tstep : cA; const char* nB = has_next ? (const char*)g.Bt + (size_t)nxt.pn * tstep : cB;
        for (int t = 0; t < nt; t += 2) {
            const bool last = (t == nt - 2);
            const char* a1 = cA + (size_t)(t + 1) * kstep;
            const char* a2 = last ? nA : cA + (size_t)(t + 2) * kstep; const char* b2 = last ? nB : cB + (size_t)(t + 2) * kstep;
            const char* a3 = a2 + kstep; const char* b3 = b2 + kstep;
            PG8_LDB(B0, 0, 0); PG8_LDB(B1, 0, 1); PG8_SCHED; PG8_LDA(At, 0, 0); PG8_STAGE(PG8_SA(1, 1), a1 + hstep, voffA);
            PG8_WAIT_V(8); PG8_WAIT_L(0); PG8_BAR; PG8_MMA(0, 0, At, B0); PG8_MMA(0, 1, At, B1); PG8_BAR; PG8_SCHED;
            PG8_LDA(At, 0, 1); PG8_STAGE(PG8_SB(0, 0), b2, voffB); PG8_STAGE(PG8_SB(0, 1), b2 + hstep, voffB); PG8_STAGE(PG8_SA(0, 0), a2, voffA);
            PG8_WAIT_V(8); PG8_WAIT_L(0); PG8_BAR; PG8_MMA(1, 0, At, B0); PG8_MMA(1, 1, At, B1); PG8_BAR; PG8_SCHED;
            PG8_LDB(B0, 1, 0); PG8_LDB(B1, 1, 1); PG8_SCHED; PG8_LDA(At, 1, 0); PG8_STAGE(PG8_SA(0, 1), a2 + hstep, voffA);
            PG8_WAIT_V(8); PG8_WAIT_L(0); PG8_BAR; PG8_MMA(0, 0, At, B0); PG8_MMA(0, 1, At, B1); PG8_BAR; PG8_SCHED;
            PG8_LDA(At, 1, 1); PG8_STAGE(PG8_SB(1, 0), b3, voffB); PG8_STAGE(PG8_SB(1, 1), b3 + hstep, voffB); PG8_STAGE(PG8_SA(1, 0), a3, voffA);
            PG8_WAIT_V(8); PG8_WAIT_L(0); PG8_BAR; PG8_MMA(1, 0, At, B0); PG8_MMA(1, 1, At, B1); PG8_BAR; PG8_SCHED;
        }
        if (wr == 0) PG8_BAR;
        E(acc, cur, wr, wc, fr, fq);
        if (!has_next) break;
#pragma unroll
        for (int a = 0; a < 2; ++a)
#pragma unroll
            for (int b = 0; b < 2; ++b)
#pragma unroll
                for (int m = 0; m < 4; ++m)
#pragma unroll
                    for (int n = 0; n < 2; ++n) acc[a][b][m][n] = (f32x4){0.f, 0.f, 0.f, 0.f};
        cur = nxt; cA = nA; cB = nB; ++ui;
        if (wr == 1) PG8_BAR;
    }
    PG8_WAIT_V(0);
    PG8_BAR;
#undef PG8_SA
#undef PG8_SB
#undef PG8_STAGE
#undef PG8_LDA
#undef PG8_LDB
#undef PG8_MMA
#undef PG8_WAIT_V
#undef PG8_WAIT_L
#undef PG8_BAR
#undef PG8_SCHED
}
}

struct Extra { float* pp; float* ps; int c0, width, keep; };

struct EpiProj {
    static constexpr bool PERM = true, ROWPERM = false;
    bf16_t* O; int ldc; Extra e0, e1;
    __device__ __forceinline__ void operator()(const f32x4 (&acc)[2][2][4][2], const pg8::Unit& u, int wr, int wc, int fr, int fq) const {
        const int colt = u.pn * 256;
        const int col0 = colt + wc * 32 + 8 * fq;
        float* xp = nullptr; float* xs = nullptr; int xc0 = 0, xw = 0, xkeep = 0;
        if (e0.width && colt >= e0.c0 && colt < e0.c0 + e0.width) { xp = e0.pp; xs = e0.ps; xc0 = e0.c0; xw = e0.width; xkeep = e0.keep; }
        else if (e1.width && colt >= e1.c0 && colt < e1.c0 + e1.width) { xp = e1.pp; xs = e1.ps; xc0 = e1.c0; xw = e1.width; xkeep = e1.keep; }
#pragma unroll
        for (int ai = 0; ai < 2; ++ai) {
            if (u.pm == 256 && ai == 1) continue;
#pragma unroll
            for (int m = 0; m < 4; ++m) {
                const int row = u.pm * 256 + ai * 128 + wr * 64 + m * 16 + fr;
                bf16_t* rowp = O + (size_t)row * ldc + col0;
#pragma unroll
                for (int bj = 0; bj < 2; ++bj) {
                    const f32x4 v0 = acc[ai][bj][m][0], v1 = acc[ai][bj][m][1];
                    u32x4 w; w.x = cvt_pk_bf16(v0[0], v0[1]); w.y = cvt_pk_bf16(v0[2], v0[3]); w.z = cvt_pk_bf16(v1[0], v1[1]); w.w = cvt_pk_bf16(v1[2], v1[3]);
                    *(u32x4*)(rowp + bj * 128) = w;
                }
                if (xw) {
                    float* d = nullptr;
                    if (row < MP) { const int t = row & (SEQ - 1), b = row >> 13; if (t >= SEQ - xkeep) d = xp + (size_t)(b * xkeep + t - (SEQ - xkeep)) * xw; }
                    else d = xs + (size_t)(row - MP) * xw;
                    if (d) { d += col0 - xc0;
#pragma unroll
                        for (int bj = 0; bj < 2; ++bj) { *(f32x4*)(d + bj * 128) = acc[ai][bj][m][0]; *(f32x4*)(d + bj * 128 + 4) = acc[ai][bj][m][1]; } }
                }
            }
        }
    }
};

struct EpiRes {
    static constexpr bool PERM = false, ROWPERM = false;
    const float* xp; const float* xs; float* out; const float* gate;
    __device__ __forceinline__ void operator()(const f32x4 (&acc)[2][2][4][2], const pg8::Unit& u, int wr, int wc, int fr, int fq) const {
        const int col0 = u.pn * 256 + wc * 32 + 4 * fq;
#pragma unroll
        for (int ai = 0; ai < 2; ++ai) {
            if (u.pm == 256 && ai == 1) continue;
#pragma unroll
            for (int m = 0; m < 4; ++m) {
                const int row = u.pm * 256 + ai * 128 + wr * 64 + m * 16 + fr;
                const float* xr = (row < MP ? xp + (size_t)row * DM : xs + (size_t)(row - MP) * DM) + col0;
                const float* gr = gate + ada_row(row) * 6144 + col0;
                float* orow = out + (size_t)row * DM + col0;
#pragma unroll
                for (int bj = 0; bj < 2; ++bj)
#pragma unroll
                    for (int n = 0; n < 2; ++n) {
                        const int c = bj * 128 + n * 16;
                        const f32x4 xv = *(const f32x4*)(xr + c), gv = *(const f32x4*)(gr + c);
                        *(f32x4*)(orow + c) = xv * ALPHA + (gv + 1.0f) * acc[ai][bj][m][n];
                    }
            }
        }
    }
};

struct EpiUp {
    static constexpr bool PERM = true, ROWPERM = true;
    bf16_t* ACT; float* UH; float* USAMP; const float* cw; const float* cb; float* convp;
    __device__ __forceinline__ void operator()(const f32x4 (&acc)[2][2][4][2], const pg8::Unit& u, int wr, int wc, int fr, int fq) const {
        const int ca0 = u.pn * 128 + wc * 32 + 8 * fq;
        if (u.pm == 256) {
#pragma unroll
            for (int m = 0; m < 4; ++m) { float* d = USAMP + (size_t)(wr * 64 + 4 * fr + m) * FF2 + ca0;
#pragma unroll
                for (int bj = 0; bj < 2; ++bj) { *(f32x4*)(d + bj * FF) = acc[0][bj][m][0]; *(f32x4*)(d + bj * FF + 4) = acc[0][bj][m][1]; } }
            return;
        }
#pragma unroll
        for (int n = 0; n < 2; ++n) {
            const int ca = ca0 + 4 * n;
            f32x4 w0[2], w1[2], w2[2], bb[2];
#pragma unroll
            for (int bj = 0; bj < 2; ++bj) { const int c = bj * FF + ca; w0[bj] = *(const f32x4*)(cw + c); w1[bj] = *(const f32x4*)(cw + FF2 + c); w2[bj] = *(const f32x4*)(cw + 2 * FF2 + c); bb[bj] = *(const f32x4*)(cb + c); }
#pragma unroll
            for (int ai = 0; ai < 2; ++ai) {
                f32x4 p2[2], p3[2];
#pragma unroll
                for (int bj = 0; bj < 2; ++bj)
#pragma unroll
                    for (int j = 0; j < 4; ++j) { p2[bj][j] = __shfl_up(acc[ai][bj][2][n][j], 1, 16); p3[bj][j] = __shfl_up(acc[ai][bj][3][n][j], 1, 16); }
                const int grp = u.pm * 4 + ai * 2 + wr;
                const int row0 = grp * 64 + 4 * fr;
#pragma unroll
                for (int m = 0; m < 4; ++m) {
                    const bool halo = (fr == 0 && m < 2) || (fr == 15 && m >= 2);
                    if (halo) { float* d = UH + ((size_t)(grp * 4 + m)) * FF2 + ca;
                        *(f32x4*)(d) = acc[ai][0][m][n]; *(f32x4*)(d + FF) = acc[ai][1][m][n]; }
                    if (fr == 15 && m >= 2 && ai == 1 && wr == 1 && (u.pm & 31) == 31) { float* d = convp + (size_t)((u.pm >> 5) * 2 + (m - 2)) * FF2 + ca;
                        *(f32x4*)(d) = acc[ai][0][m][n]; *(f32x4*)(d + FF) = acc[ai][1][m][n]; }
                    if (fr == 0 && m < 2) continue;
                    f32x4 y[2];
#pragma unroll
                    for (int bj = 0; bj < 2; ++bj) {
                        const f32x4 u0 = acc[ai][bj][m][n];
                        const f32x4 u1 = (m >= 1) ? acc[ai][bj][m >= 1 ? m - 1 : 0][n] : p3[bj];
                        const f32x4 u2 = (m >= 2) ? acc[ai][bj][m >= 2 ? m - 2 : 0][n] : (m == 1 ? p3[bj] : p2[bj]);
                        y[bj] = bb[bj] + w2[bj] * u0 + w1[bj] * u1 + w0[bj] * u2;
                    }
                    float a0 = gelu_tanh(y[1][0]) * y[0][0], a1 = gelu_tanh(y[1][1]) * y[0][1], a2 = gelu_tanh(y[1][2]) * y[0][2], a3 = gelu_tanh(y[1][3]) * y[0][3];
                    u32x2 w; w.x = cvt_pk_bf16(a0, a1); w.y = cvt_pk_bf16(a2, a3);
                    *(u32x2*)(ACT + (size_t)(row0 + m) * FF + ca) = w;
                }
            }
        }
    }
};

struct SgArgs { const bf16_t* A; const bf16_t* Wt; int N, K, mode; bf16_t* O; int ldc; Extra e0, e1; const float* xs; float* out; const float* gate; float* usamp; };
__device__ __forceinline__ void sample_gemm(const SgArgs a) {
    const int tid = opaque_tid(), lane = tid & 63, w = __builtin_amdgcn_readfirstlane(tid >> 6);
    const int l15 = lane & 15, quad = lane >> 4;
    const int row = MP + 16 * w + l15;
    const bf16_t* ap = a.A + (size_t)row * a.K + quad * 8;
    for (int item = blockIdx.x; item < a.N / 16; item += gridDim.x) {
        const int col0 = item * 16;
        const bf16_t* bp = a.Wt + (size_t)(col0 + l15) * a.K + quad * 8;
        f32x4 acc = (f32x4){0.f, 0.f, 0.f, 0.f};
        for (int k0 = 0; k0 < a.K; k0 += 256) {
            bf16x8 af[8], bf[8];
#pragma unroll
            for (int i = 0; i < 8; ++i) { af[i] = *(const bf16x8*)(ap + k0 + 32 * i); bf[i] = *(const bf16x8*)(bp + k0 + 32 * i); }
#pragma unroll
            for (int i = 0; i < 8; ++i) acc = __builtin_amdgcn_mfma_f32_16x16x32_bf16(bf[i], af[i], acc, 0, 0, 0);
        }
        const int col = col0 + quad * 4;
        asm volatile("s_nop 15\n\ts_nop 15\n\ts_nop 15" : "+v"(acc));
        if (a.mode == 0) {
            u32x2 w2; w2.x = cvt_pk_bf16(acc[0], acc[1]); w2.y = cvt_pk_bf16(acc[2], acc[3]); *(u32x2*)(a.O + (size_t)row * a.ldc + col) = w2;
            if (a.e0.width && col0 >= a.e0.c0 && col0 < a.e0.c0 + a.e0.width) *(f32x4*)(a.e0.ps + (size_t)(row - MP) * a.e0.width + (col - a.e0.c0)) = acc;
            else if (a.e1.width && col0 >= a.e1.c0 && col0 < a.e1.c0 + a.e1.width) *(f32x4*)(a.e1.ps + (size_t)(row - MP) * a.e1.width + (col - a.e1.c0)) = acc;
        } else if (a.mode == 1) {
            const f32x4 xv = *(const f32x4*)(a.xs + (size_t)(row - MP) * DM + col), gv = *(const f32x4*)(a.gate + ada_row(row) * 6144 + col);
            *(f32x4*)(a.out + (size_t)row * DM + col) = xv * ALPHA + (gv + 1.0f) * acc;
        } else {
            const int t = col >> 8, r = col & 255; const int oc = r < 128 ? t * 128 + r : FF + t * 128 + (r - 128);
            *(f32x4*)(a.usamp + (size_t)(row - MP) * FF2 + oc) = acc;
        }
    }
}

__device__ __forceinline__ void p0_ada(unsigned char* lds, const Params& P) {
    const int tid = opaque_tid(), lane = tid & 63, w = __builtin_amdgcn_readfirstlane(tid >> 6);
    float* scT = (float*)lds;
    float* red = scT + 16384;
    const float* cp = P.in[2]; const float* cs = P.in[3];
    for (int idx = tid; idx < 16384; idx += 512) { const int r = idx >> 10, k = idx & 1023; const float c = r < 8 ? cp[r * 1024 + k] : cs[(r - 8) * 1024 + k]; scT[k * 16 + r] = c / (1.0f + __expf(-c)); }
    __syncthreads();
    float* ada = (float*)(P.ws + WS_ADA); float* adakv = (float*)(P.ws + WS_ADAKV);
    for (int item = blockIdx.x; item < 416; item += gridDim.x) {
        { const int gc = item * 64 + lane; const float* W; int ldw;
          if (gc < 24576) { const int l = gc / 6144, n = gc - l * 6144; W = P.in[9] + (size_t)l * 1024 * 6144 + n; ldw = 6144; }
          else { W = P.in[17] + (gc - 24576); ldw = 2048; }
          float acc[16];
#pragma unroll
          for (int r = 0; r < 16; ++r) acc[r] = 0.f;
#pragma unroll 8
          for (int kk = 0; kk < 128; ++kk) { const int k = w * 128 + kk; const float wv = W[(size_t)k * ldw];
              const f32x4 s0 = *(const f32x4*)(scT + k * 16), s1 = *(const f32x4*)(scT + k * 16 + 4), s2 = *(const f32x4*)(scT + k * 16 + 8), s3 = *(const f32x4*)(scT + k * 16 + 12);
#pragma unroll
              for (int j = 0; j < 4; ++j) { acc[j] += s0[j] * wv; acc[4 + j] += s1[j] * wv; acc[8 + j] += s2[j] * wv; acc[12 + j] += s3[j] * wv; } }
#pragma unroll
          for (int r = 0; r < 16; ++r) red[(w * 16 + r) * 64 + lane] = acc[r]; }
        __syncthreads();
        for (int idx = tid; idx < 1024; idx += 512) { const int r = idx >> 6, cl = idx & 63; float s = 0.f;
#pragma unroll
            for (int ww = 0; ww < 8; ++ww) s += red[(ww * 16 + r) * 64 + cl];
            const int gc = item * 64 + cl;
            if (gc < 24576) { const int l = gc / 6144, n = gc - l * 6144; ada[(size_t)(l * 16 + r) * 6144 + n] = s + P.in[10][l * 6144 + n]; }
            else { const int n = gc - 24576; adakv[r * 2048 + n] = s + P.in[18][n]; } }
        __syncthreads();
    }
}

__device__ __forceinline__ int upmap(int n) { return n < FF ? (n >> 7) * 256 + (n & 127) : ((n - FF) >> 7) * 256 + 128 + ((n - FF) & 127); }

__device__ __forceinline__ void p0_transpose_item(const float* W, int K, int N, bf16_t* WT, int up, float* scr, int item, int lane) {
    const int nblk = N / 32, kb = item / nblk, nb = item % nblk, k0 = 64 * kb, n0 = 32 * nb;
    const int d0 = up ? upmap(n0) : n0;
#pragma unroll 8
    for (int i = 0; i < 32; ++i) { const int kk = 2 * i + (lane >> 5); scr[kk * 33 + (lane & 31)] = W[(size_t)(k0 + kk) * N + n0 + (lane & 31)]; }
    asm volatile("s_waitcnt lgkmcnt(0)" ::: "memory");
    const int c = lane & 7;
#pragma unroll
    for (int j = 0; j < 4; ++j) { const int n = (lane >> 3) + 8 * j; const float* s = scr + (8 * c) * 33 + n;
        u32x4 o; o.x = cvt_pk_bf16(s[0 * 33], s[1 * 33]); o.y = cvt_pk_bf16(s[2 * 33], s[3 * 33]); o.z = cvt_pk_bf16(s[4 * 33], s[5 * 33]); o.w = cvt_pk_bf16(s[6 * 33], s[7 * 33]);
        *(u32x4*)(WT + (size_t)(d0 + n) * K + k0 + 8 * c) = o; }
    asm volatile("s_waitcnt lgkmcnt(0)" ::: "memory");
}

__device__ __forceinline__ void p0_weights(unsigned char* lds, const Params& P) {
    const int tid = opaque_tid(), lane = tid & 63, w = __builtin_amdgcn_readfirstlane(tid >> 6);
    float* scr = (float*)(lds + w * 16384);
    const int gw = blockIdx.x * 8 + w, NGW = gridDim.x * 8;
    unsigned char* ws = P.ws;
    for (int it = gw; it < 22528; it += NGW) {
        int r = it;
        if (r < 1536) { const int l = r / 768; r -= l * 768; p0_transpose_item(P.in[13] + (size_t)l * 1024 * 1536, 1024, 1536, (bf16_t*)(ws + WS_WQKV) + (size_t)l * 1536 * 1024, 0, scr, r, lane); continue; } r -= 1536;
        if (r < 1024) { const int l = r / 512; r -= l * 512; p0_transpose_item(P.in[14] + (size_t)l * 1024 * 1024, 1024, 1024, (bf16_t*)(ws + WS_WOA) + (size_t)l * 1024 * 1024, 0, scr, r, lane); continue; } r -= 1024;
        if (r < 1024) { p0_transpose_item(P.in[19], 1024, 2048, (bf16_t*)(ws + WS_WKV), 0, scr, r, lane); continue; } r -= 1024;
        if (r < 1024) { const int l = r / 512; r -= l * 512; p0_transpose_item(P.in[20] + (size_t)l * 1024 * 1024, 1024, 1024, (bf16_t*)(ws + WS_WQB) + (size_t)l * 1024 * 1024, 0, scr, r, lane); continue; } r -= 1024;
        if (r < 1024) { const int l = r / 512; r -= l * 512; p0_transpose_item(P.in[21] + (size_t)l * 1024 * 1024, 1024, 1024, (bf16_t*)(ws + WS_WOB) + (size_t)l * 1024 * 1024, 0, scr, r, lane); continue; } r -= 1024;
        if (r < 11264) { const int l = r / 2816; r -= l * 2816; p0_transpose_item(P.in[23] + (size_t)l * 1024 * FF2, 1024, FF2, (bf16_t*)(ws + WS_WUP) + (size_t)l * FF2 * 1024, 1, scr, r, lane); continue; } r -= 11264;
        { const int l = r / 1408; r -= l * 1408; p0_transpose_item(P.in[26] + (size_t)l * FF * 1024, FF, 1024, (bf16_t*)(ws + WS_WDN) + (size_t)l * 1024 * FF, 0, scr, r, lane); }
    }
}

__device__ __forceinline__ void row_pass(const float* srcp, const float* srcs, bool do_ln, const float* lg, const float* lb, float* xout,
                                         const float* ada_l, int sh_chunk, int sc_chunk, bf16_t* H, const float* adakv, bf16_t* H2) {
    const int tid = opaque_tid(), lane = tid & 63, w = __builtin_amdgcn_readfirstlane(tid >> 6);
    const int gw = blockIdx.x * 8 + w, NGW = gridDim.x * 8;
    for (int r0 = gw * 4; r0 < MREAL; r0 += NGW * 4) {
        f32x4 v[4][4];
#pragma unroll
        for (int rr = 0; rr < 4; ++rr) { const int row = r0 + rr;
            const float* xr = (row < MP ? srcp + (size_t)row * DM : srcs + (size_t)(row - MP) * DM) + 4 * lane;
#pragma unroll
            for (int j = 0; j < 4; ++j) v[rr][j] = *(const f32x4*)(xr + 256 * j); }
#pragma unroll
        for (int rr = 0; rr < 4; ++rr) { const int row = r0 + rr;
            if (do_ln) {
                float s = 0.f;
#pragma unroll
                for (int j = 0; j < 4; ++j) s += (v[rr][j][0] + v[rr][j][1]) + (v[rr][j][2] + v[rr][j][3]);
                const float mean = wave_sum(s) * (1.f / DM); float s2 = 0.f;
#pragma unroll
                for (int j = 0; j < 4; ++j) { v[rr][j] = v[rr][j] - mean; s2 += (v[rr][j][0] * v[rr][j][0] + v[rr][j][1] * v[rr][j][1]) + (v[rr][j][2] * v[rr][j][2] + v[rr][j][3] * v[rr][j][3]); }
                const float rstd = 1.f / sqrtf(wave_sum(s2) * (1.f / DM) + LN_EPS);
#pragma unroll
                for (int j = 0; j < 4; ++j) { const f32x4 gg = *(const f32x4*)(lg + 4 * lane + 256 * j), bb = *(const f32x4*)(lb + 4 * lane + 256 * j); v[rr][j] = v[rr][j] * rstd * gg + bb; }
            }
            if (xout) {
                float* xo = xout + (size_t)row * DM + 4 * lane;
#pragma unroll
                for (int j = 0; j < 4; ++j) *(f32x4*)(xo + 256 * j) = v[rr][j];
            }
            const int ar = ada_row(row);
            if (H) {
                const float* shp = ada_l + (size_t)ar * 6144 + sh_chunk * 1024 + 4 * lane; const float* scp = ada_l + (size_t)ar * 6144 + sc_chunk * 1024 + 4 * lane;
                bf16_t* ho = H + (size_t)row * DM + 4 * lane;
#pragma unroll
                for (int j = 0; j < 4; ++j) { const f32x4 sh = *(const f32x4*)(shp + 256 * j), sc = *(const f32x4*)(scp + 256 * j); const f32x4 h = v[rr][j] * (sc + 1.0f) + sh;
                    u32x2 w2; w2.x = cvt_pk_bf16(h[0], h[1]); w2.y = cvt_pk_bf16(h[2], h[3]); *(u32x2*)(ho + 256 * j) = w2; }
            }
            if (H2) {
                const float* shp = adakv + (size_t)ar * 2048 + 4 * lane; const float* scp = shp + 1024;
                bf16_t* ho = H2 + (size_t)row * DM + 4 * lane;
#pragma unroll
                for (int j = 0; j < 4; ++j) { const f32x4 sh = *(const f32x4*)(shp + 256 * j), sc = *(const f32x4*)(scp + 256 * j); const f32x4 h = v[rr][j] * (sc + 1.0f) + sh;
                    u32x2 w2; w2.x = cvt_pk_bf16(h[0], h[1]); w2.y = cvt_pk_bf16(h[2], h[3]); *(u32x2*)(ho + 256 * j) = w2; }
            }
        }
    }
}

__device__ __forceinline__ int t5_bucket(int rel) {
    const int n = rel < 0 ? -rel : rel; const int base = rel > 0 ? 16 : 0;
    if (n < 8) return base + n;
    int lg = (31 - __builtin_clz((unsigned)(n * n))) - 6 + 8; if (lg > 15) lg = 15;
    return base + lg;
}
constexpr int KS_STRIDE = 72, VT_STRIDE = 68, TAB_STRIDE = 264;
constexpr int LDS_KS = 0, LDS_VT = 2 * 64 * KS_STRIDE * 2, LDS_TAB = LDS_VT + 2 * 64 * VT_STRIDE * 2, LDS_SC = LDS_TAB + 16 * TAB_STRIDE * 4;
static_assert(LDS_SC + 8 * 544 * 4 <= 131072, "attn lds");

template <int MODE> __device__ __forceinline__ void attn_build_tab(unsigned char* lds, const float* src) {
    const int tid = opaque_tid();
    float* tab = (float*)(lds + LDS_TAB);
    if (MODE == 0) { for (int idx = tid; idx < 16 * 256; idx += 512) { const int h = idx >> 8, i = idx & 255; tab[h * TAB_STRIDE + i] = src[t5_bucket(i - 191) * 16 + h] * LOG2E; } }
    else { for (int idx = tid; idx < 16 * 257; idx += 512) { const int h = idx / 257, i = idx - h * 257; tab[h * TAB_STRIDE + i] = src[idx] * LOG2E; } }
    __syncthreads();
}

template <int MODE> __device__ __forceinline__ void attn_chunk(const bf16_t* kb, const bf16_t* vb, const float* tabh, const bf16x8 (&qf)[2], f32x4 (&o)[4], float& mrun, float& lsum,
                                                               int j, int cw, int qpos, int l15, int quad) {
    bf16x8 kf[4][2]; u32x4 vf[2][4]; f32x4 tb[4];
    const bool cbias = (MODE == 1 && cw - j >= 3);
#pragma unroll
    for (int t = 0; t < 4; ++t)
#pragma unroll
        for (int kk = 0; kk < 2; ++kk) kf[t][kk] = *(const bf16x8*)(kb + (16 * t + l15) * KS_STRIDE + kk * 32 + quad * 8);
    if (cbias) { const float bc = tabh[256];
#pragma unroll
        for (int t = 0; t < 4; ++t) tb[t] = (f32x4){bc, bc, bc, bc};
    } else {
#pragma unroll
        for (int t = 0; t < 4; ++t)
#pragma unroll
            for (int jj = 0; jj < 4; ++jj) { const int kpos = j * 64 + 16 * t + quad * 4 + jj; int idx;
                if (MODE == 0) idx = kpos - qpos + 191; else { int d = qpos - kpos; d = d < -128 ? -128 : (d > 128 ? 128 : d); idx = d + 128; }
                tb[t][jj] = tabh[idx]; }
    }
#pragma unroll
    for (int kb2 = 0; kb2 < 2; ++kb2)
#pragma unroll
        for (int dt = 0; dt < 4; ++dt) { const bf16_t* vp = vb + (16 * dt + l15) * VT_STRIDE + 32 * kb2 + quad * 4;
            const u32x2 lo = *(const u32x2*)vp, hi = *(const u32x2*)(vp + 16); vf[kb2][dt].x = lo.x; vf[kb2][dt].y = lo.y; vf[kb2][dt].z = hi.x; vf[kb2][dt].w = hi.y; }
    __builtin_amdgcn_sched_barrier(0);
    f32x4 s[4];
#pragma unroll
    for (int t = 0; t < 4; ++t) { s[t] = (f32x4){0.f, 0.f, 0.f, 0.f};
#pragma unroll
        for (int kk = 0; kk < 2; ++kk) s[t] = __builtin_amdgcn_mfma_f32_16x16x32_bf16(kf[t][kk], qf[kk], s[t], 0, 0, 0); }
    float mx = -1e30f;
#pragma unroll
    for (int t = 0; t < 4; ++t) { s[t] = s[t] * SCALE2 + tb[t]; mx = fmaxf(mx, fmaxf(fmaxf(s[t][0], s[t][1]), fmaxf(s[t][2], s[t][3]))); }
    mx = fmaxf(mx, __shfl_xor(mx, 16)); mx = fmaxf(mx, __shfl_xor(mx, 32));
    const float mnew = fmaxf(mrun, mx); const float alpha = __builtin_amdgcn_exp2f(mrun - mnew); mrun = mnew;
    float ps = 0.f;
#pragma unroll
    for (int t = 0; t < 4; ++t)
#pragma unroll
        for (int jj = 0; jj < 4; ++jj) { const float p = __builtin_amdgcn_exp2f(s[t][jj] - mnew); s[t][jj] = p; ps += p; }
    lsum = lsum * alpha + ps;
#pragma unroll
    for (int dt = 0; dt < 4; ++dt) o[dt] = o[dt] * alpha;
#pragma unroll
    for (int kb2 = 0; kb2 < 2; ++kb2) {
        u32x4 pw; pw.x = cvt_pk_bf16(s[2 * kb2][0], s[2 * kb2][1]); pw.y = cvt_pk_bf16(s[2 * kb2][2], s[2 * kb2][3]); pw.z = cvt_pk_bf16(s[2 * kb2 + 1][0], s[2 * kb2 + 1][1]); pw.w = cvt_pk_bf16(s[2 * kb2 + 1][2], s[2 * kb2 + 1][3]);
        const bf16x8 pf = __builtin_bit_cast(bf16x8, pw);
#pragma unroll
        for (int dt = 0; dt < 4; ++dt) o[dt] = __builtin_amdgcn_mfma_f32_16x16x32_bf16(__builtin_bit_cast(bf16x8, vf[kb2][dt]), pf, o[dt], 0, 0, 0);
    }
}

template <int MODE> __device__ __forceinline__ void attn_unit_dec(int t, int G, int& b, int& hx, int& cx) {
    if (G == 256) { const int k = blockIdx.x, x = k & 7, i = k >> 3;
        if (MODE == 0) { const int hp = i & 1, r = (i >> 1) & 3, st = x * 4 + (i >> 3); b = st >> 2; hx = (st & 3) * 2 + hp; cx = 4 * t + r; }
        else { const int h = i & 1, st = x * 16 + (i >> 1); b = st >> 4; hx = st & 15; cx = 2 * t + h; }
    } else { const int u = blockIdx.x + t * G;
        if (MODE == 0) { hx = u & 7; cx = (u >> 3) & 127; b = u >> 10; } else { hx = u & 15; cx = (u >> 4) & 63; b = u >> 10; } }
}
template <int MODE> __device__ __forceinline__ void attn_prompt(unsigned char* lds, const bf16_t* Q, const bf16_t* KV, bf16_t* O, const float* sinks) {
    const int tid = opaque_tid(), lane = tid & 63, w = __builtin_amdgcn_readfirstlane(tid >> 6);
    constexpr int NBACK = MODE == 0 ? 2 : 8;
    constexpr int LDQ = MODE == 0 ? 1536 : 1024, LDKV = MODE == 0 ? 1536 : 2048;
    bf16_t* Ks = (bf16_t*)(lds + LDS_KS); bf16_t* Vt = (bf16_t*)(lds + LDS_VT); const float* tab = (const float*)(lds + LDS_TAB);
    const int l15 = lane & 15, quad = lane >> 4;
    const int skey = tid >> 3, spart = tid & 7;
    const int G = gridDim.x;
    const int NU = (G == 256) ? 32 : (8192 - (int)blockIdx.x + G - 1) / G;
    int lt = 0, lj = 0, ljhi = 0; const bf16_t* lkb = KV; const bf16_t* lvb = KV;
#define AT_LC_SETUP() do { if (lt < NU) { int b_, hx_, cx_; attn_unit_dec<MODE>(lt, G, b_, hx_, cx_); \
        if (MODE == 0) { lj = cx_ - 2 < 0 ? 0 : cx_ - 2; ljhi = cx_; lkb = KV + (size_t)b_ * SEQ * LDKV + 1024 + (hx_ >> 1) * 64; lvb = lkb + 256; } \
        else { lj = 2 * cx_ - 8 < 0 ? 0 : 2 * cx_ - 8; ljhi = 2 * cx_ + 1; lkb = KV + (size_t)b_ * SEQ * LDKV + hx_ * 64; lvb = lkb + 1024; } } } while (0)
#define AT_LC_LOAD(KR, VR) do { if (lt < NU) { KR = *(const u32x4*)(lkb + (size_t)(lj * 64 + skey) * LDKV + spart * 8); VR = *(const u32x4*)(lvb + (size_t)(lj * 64 + skey) * LDKV + spart * 8); \
        if (++lj > ljhi) { ++lt; AT_LC_SETUP(); } } } while (0)
    int ct = 0, cj = 0, cjlo = 0, cjhi = 0, head = 0, cw = 0, qpos = 0; size_t qrow = 0;
    bf16x8 qf[2], qn[2];
    f32x4 o[4]; float mrun = 0.f, lsum = 0.f;
#define AT_QLOAD(T) do { if ((T) < NU) { int b_, hx_, cx_; attn_unit_dec<MODE>((T), G, b_, hx_, cx_); \
        const int hd_ = MODE == 0 ? (hx_ >> 1) * 4 + (hx_ & 1) * 2 + (w >> 2) : hx_; const int cw_ = MODE == 0 ? cx_ : 2 * cx_ + (w >> 2); \
        const size_t qr_ = (size_t)b_ * SEQ + cw_ * 64 + (w & 3) * 16 + l15; \
        qn[0] = *(const bf16x8*)(Q + qr_ * LDQ + hd_ * 64 + quad * 8); qn[1] = *(const bf16x8*)(Q + qr_ * LDQ + hd_ * 64 + 32 + quad * 8); } } while (0)
#define AT_CC_SETUP() do { if (ct < NU) { int b_, hx_, cx_; attn_unit_dec<MODE>(ct, G, b_, hx_, cx_); \
        if (MODE == 0) { cjlo = cx_ - 2 < 0 ? 0 : cx_ - 2; cjhi = cx_; head = (hx_ >> 1) * 4 + (hx_ & 1) * 2 + (w >> 2); cw = cx_; } \
        else { cjlo = 2 * cx_ - 8 < 0 ? 0 : 2 * cx_ - 8; cjhi = 2 * cx_ + 1; head = hx_; cw = 2 * cx_ + (w >> 2); } \
        cj = cjlo; qpos = cw * 64 + (w & 3) * 16 + l15; qrow = (size_t)b_ * SEQ + qpos; } } while (0)
    u32x4 kr0, vr0, kr1, vr1;
    kr0 = vr0 = kr1 = vr1 = (u32x4){0u, 0u, 0u, 0u};
    AT_LC_SETUP(); AT_LC_LOAD(kr0, vr0); AT_LC_LOAD(kr1, vr1);
    AT_QLOAD(0); AT_CC_SETUP();
#define AT_STEP(KR, VR, BUF) do { \
        { bf16_t* kd = Ks + (BUF) * 64 * KS_STRIDE + skey * KS_STRIDE + spart * 8; *(u32x4*)kd = KR; \
          bf16_t* vd = Vt + (BUF) * 64 * VT_STRIDE + (spart * 8) * VT_STRIDE + skey; \
          vd[0 * VT_STRIDE] = (bf16_t)(VR.x & 0xffff); vd[1 * VT_STRIDE] = (bf16_t)(VR.x >> 16); vd[2 * VT_STRIDE] = (bf16_t)(VR.y & 0xffff); vd[3 * VT_STRIDE] = (bf16_t)(VR.y >> 16); \
          vd[4 * VT_STRIDE] = (bf16_t)(VR.z & 0xffff); vd[5 * VT_STRIDE] = (bf16_t)(VR.z >> 16); vd[6 * VT_STRIDE] = (bf16_t)(VR.w & 0xffff); vd[7 * VT_STRIDE] = (bf16_t)(VR.w >> 16); } \
        AT_LC_LOAD(KR, VR); \
        asm volatile("s_waitcnt lgkmcnt(0)" ::: "memory"); __builtin_amdgcn_s_barrier(); asm volatile("" ::: "memory"); \
        if (cj == cjlo) { qf[0] = qn[0]; qf[1] = qn[1]; AT_QLOAD(ct + 1); \
            _Pragma("unroll") for (int dt = 0; dt < 4; ++dt) o[dt] = (f32x4){0.f, 0.f, 0.f, 0.f}; \
            if (MODE == 0) { mrun = sinks[head] * LOG2E; lsum = quad == 0 ? 1.0f : 0.0f; } else { mrun = -1e30f; lsum = 0.f; } } \
        if (cj >= cw - NBACK && cj <= cw) attn_chunk<MODE>(Ks + (BUF) * 64 * KS_STRIDE, Vt + (BUF) * 64 * VT_STRIDE, tab + head * TAB_STRIDE, qf, o, mrun, lsum, cj, cw, qpos, l15, quad); \
        if (cj == cjhi) { float ls_ = lsum; ls_ += __shfl_xor(ls_, 16); ls_ += __shfl_xor(ls_, 32); const float inv_ = 1.0f / ls_; \
            bf16_t* op_ = O + qrow * DM + head * 64 + quad * 4; \
            _Pragma("unroll") for (int dt = 0; dt < 4; ++dt) { u32x2 w2; w2.x = cvt_pk_bf16(o[dt][0] * inv_, o[dt][1] * inv_); w2.y = cvt_pk_bf16(o[dt][2] * inv_, o[dt][3] * inv_); *(u32x2*)(op_ + 16 * dt) = w2; } \
            ++ct; AT_CC_SETUP(); } else ++cj; \
    } while (0)
    while (ct < NU) {
        AT_STEP(kr0, vr0, 0);
        if (ct >= NU) break;
        AT_STEP(kr1, vr1, 1);
    }
    __syncthreads();
#undef AT_LC_SETUP
#undef AT_LC_LOAD
#undef AT_QLOAD
#undef AT_CC_SETUP
#undef AT_STEP
}


template <int MODE> __device__ __forceinline__ void attn_sample(unsigned char* lds, const bf16_t* Q, const bf16_t* KV, bf16_t* O, const float* ck_all, const float* cv_all,
                                                                const float* tabsrc, const float* sinks) {
    const int tid = opaque_tid(), lane = tid & 63, w = __builtin_amdgcn_readfirstlane(tid >> 6);
    constexpr int P = MODE == 0 ? 128 : 512, NK = P + 16;
    constexpr int LDQ = MODE == 0 ? 1536 : 1024, LDKV = MODE == 0 ? 1536 : 2048, CST = MODE == 0 ? 256 : 1024;
    float* sc = (float*)(lds + LDS_SC) + w * 544;
    const int kq = lane >> 4, dl = lane & 15;
    for (int task = blockIdx.x * 8 + w; task < 2048; task += gridDim.x * 8) {
        const int i = task & 15, head = (task >> 4) & 15, b = task >> 8;
        const size_t srow = (size_t)MP + b * 16 + i;
        const float* ck; const float* cv; const bf16_t* nk; const bf16_t* nv;
        if (MODE == 0) { const int kvh = head >> 2; ck = ck_all + ((size_t)b * 128 * 4 + kvh) * 64; cv = cv_all + ((size_t)b * 128 * 4 + kvh) * 64; nk = KV + ((size_t)MP + b * 16) * LDKV + 1024 + kvh * 64; nv = nk + 256; }
        else { ck = ck_all + ((size_t)b * 512 * 16 + head) * 64; cv = cv_all + ((size_t)b * 512 * 16 + head) * 64; nk = KV + ((size_t)MP + b * 16) * LDKV + head * 64; nv = nk + 1024; }
        f32x4 q4; { const u32x2 qw = *(const u32x2*)(Q + srow * LDQ + head * 64 + 4 * dl); q4[0] = bf2f(qw.x & 0xffff); q4[1] = bf2f(qw.x >> 16); q4[2] = bf2f(qw.y & 0xffff); q4[3] = bf2f(qw.y >> 16); }
#define AS_SCORE(KEY, K4) do { float part = (q4[0] * K4[0] + q4[1] * K4[1]) + (q4[2] * K4[2] + q4[3] * K4[3]); \
            part += __shfl_xor(part, 1); part += __shfl_xor(part, 2); part += __shfl_xor(part, 4); part += __shfl_xor(part, 8); \
            if (dl == 0) { float bias; \
                if (MODE == 0) bias = tabsrc[t5_bucket((KEY) - 128 - i) * 16 + head]; \
                else { int d = (2048 + i) - (1536 + (KEY)); d = d < -128 ? -128 : (d > 128 ? 128 : d); bias = tabsrc[head * 257 + d + 128]; } \
                sc[(KEY)] = part * 0.125f + bias; } } while (0)
        for (int g0 = 0; g0 < P / 4; g0 += 8) {
            f32x4 k4[8];
#pragma unroll
            for (int gg = 0; gg < 8; ++gg) k4[gg] = *(const f32x4*)(ck + (size_t)(4 * (g0 + gg) + kq) * CST + 4 * dl);
#pragma unroll
            for (int gg = 0; gg < 8; ++gg) AS_SCORE(4 * (g0 + gg) + kq, k4[gg]);
        }
        {
            u32x2 kw[4];
#pragma unroll
            for (int gg = 0; gg < 4; ++gg) kw[gg] = *(const u32x2*)(nk + (size_t)(4 * gg + kq) * LDKV + 4 * dl);
#pragma unroll
            for (int gg = 0; gg < 4; ++gg) { f32x4 k4; k4[0] = bf2f(kw[gg].x & 0xffff); k4[1] = bf2f(kw[gg].x >> 16); k4[2] = bf2f(kw[gg].y & 0xffff); k4[3] = bf2f(kw[gg].y >> 16); AS_SCORE(P + 4 * gg + kq, k4); }
        }
#undef AS_SCORE
        asm volatile("s_waitcnt lgkmcnt(0)" ::: "memory");
        float mx = MODE == 0 ? sinks[head] : -1e30f;
        for (int key = lane; key < NK; key += 64) mx = fmaxf(mx, sc[key]);
        mx = wave_max(mx);
        float sum = 0.f;
        for (int key = lane; key < NK; key += 64) { const float e = __expf(sc[key] - mx); sc[key] = e; sum += e; }
        sum = wave_sum(sum);
        if (MODE == 0) sum += __expf(sinks[head] - mx);
        asm volatile("s_waitcnt lgkmcnt(0)" ::: "memory");
        f32x4 acc = (f32x4){0.f, 0.f, 0.f, 0.f};
        for (int g0 = 0; g0 < P / 4; g0 += 8) {
            f32x4 v4[8];
#pragma unroll
            for (int gg = 0; gg < 8; ++gg) v4[gg] = *(const f32x4*)(cv + (size_t)(4 * (g0 + gg) + kq) * CST + 4 * dl);
#pragma unroll
            for (int gg = 0; gg < 8; ++gg) acc = acc + v4[gg] * sc[4 * (g0 + gg) + kq];
        }
        {
            u32x2 kw[4];
#pragma unroll
            for (int gg = 0; gg < 4; ++gg) kw[gg] = *(const u32x2*)(nv + (size_t)(4 * gg + kq) * LDKV + 4 * dl);
#pragma unroll
            for (int gg = 0; gg < 4; ++gg) { f32x4 v4; v4[0] = bf2f(kw[gg].x & 0xffff); v4[1] = bf2f(kw[gg].x >> 16); v4[2] = bf2f(kw[gg].y & 0xffff); v4[3] = bf2f(kw[gg].y >> 16); acc = acc + v4 * sc[P + 4 * gg + kq]; }
        }
#pragma unroll
        for (int j = 0; j < 4; ++j) { acc[j] += __shfl_xor(acc[j], 16); acc[j] += __shfl_xor(acc[j], 32); }
        const float inv = 1.0f / sum;
        if (kq == 0) { u32x2 w2; w2.x = cvt_pk_bf16(acc[0] * inv, acc[1] * inv); w2.y = cvt_pk_bf16(acc[2] * inv, acc[3] * inv); *(u32x2*)(O + srow * DM + head * 64 + 4 * dl) = w2; }
        asm volatile("s_waitcnt lgkmcnt(0)" ::: "memory");
    }
}

__device__ __forceinline__ void conv_act4(const f32x4 (&ua)[3], const f32x4 (&ug)[3], const float* cw, const float* cb, int c, bf16_t* dst) {
    const f32x4 ya = *(const f32x4*)(cb + c) + *(const f32x4*)(cw + 2 * FF2 + c) * ua[0] + *(const f32x4*)(cw + FF2 + c) * ua[1] + *(const f32x4*)(cw + c) * ua[2];
    const f32x4 yg = *(const f32x4*)(cb + FF + c) + *(const f32x4*)(cw + 2 * FF2 + FF + c) * ug[0] + *(const f32x4*)(cw + FF2 + FF + c) * ug[1] + *(const f32x4*)(cw + FF + c) * ug[2];
    u32x2 w; w.x = cvt_pk_bf16(gelu_tanh(yg[0]) * ya[0], gelu_tanh(yg[1]) * ya[1]); w.y = cvt_pk_bf16(gelu_tanh(yg[2]) * ya[2], gelu_tanh(yg[3]) * ya[3]);
    *(u32x2*)dst = w;
}
__device__ __forceinline__ void fixup_phase(const Params& P, int l) {
    const int tid = opaque_tid();
    const float* UH = (const float*)(P.ws + WS_UH); const float* US = (const float*)(P.ws + WS_USAMP); bf16_t* ACT = (bf16_t*)(P.ws + WS_ACT);
    const float* cw = P.in[24] + (size_t)l * 3 * FF2; const float* cb = P.in[25] + (size_t)l * FF2;
    const float* st = P.in[8] + (size_t)l * 8 * 2 * FF2; float* cvs = P.out + O_CVS + (size_t)l * 8 * 2 * FF2;
    const int gt = blockIdx.x * 512 + tid, NT = gridDim.x * 512;
    const f32x4 z = (f32x4){0.f, 0.f, 0.f, 0.f};
    for (int idx = gt; idx < 1024 * 2 * 704; idx += NT) {
        const int cq = idx % 704, rr = (idx / 704) & 1, g = idx / 1408, c = 4 * cq;
        const bool first = (g & 127) == 0;
        const float* r0 = UH + ((size_t)g * 4 + rr) * FF2;
        const float* r1 = rr == 0 ? UH + ((size_t)(g - 1) * 4 + 3) * FF2 : UH + ((size_t)g * 4 + 0) * FF2;
        const float* r2 = rr == 0 ? UH + ((size_t)(g - 1) * 4 + 2) * FF2 : UH + ((size_t)(g - 1) * 4 + 3) * FF2;
        f32x4 ua[3], ug[3];
        ua[0] = *(const f32x4*)(r0 + c); ug[0] = *(const f32x4*)(r0 + FF + c);
        if (rr == 0 && first) { ua[1] = z; ug[1] = z; } else { ua[1] = *(const f32x4*)(r1 + c); ug[1] = *(const f32x4*)(r1 + FF + c); }
        if (first) { ua[2] = z; ug[2] = z; } else { ua[2] = *(const f32x4*)(r2 + c); ug[2] = *(const f32x4*)(r2 + FF + c); }
        conv_act4(ua, ug, cw, cb, c, ACT + (size_t)(g * 64 + rr) * FF + c);
    }
    for (int idx = gt; idx < 128 * 704; idx += NT) {
        const int cq = idx % 704, s = idx / 704, c = 4 * cq, b = s >> 4, t = s & 15;
        const float* r0 = US + (size_t)s * FF2;
        const float* r1 = t >= 1 ? US + (size_t)(s - 1) * FF2 : st + (size_t)(b * 2 + 1) * FF2;
        const float* r2 = t >= 2 ? US + (size_t)(s - 2) * FF2 : st + (size_t)(b * 2 + t) * FF2;
        f32x4 ua[3], ug[3];
        ua[0] = *(const f32x4*)(r0 + c); ug[0] = *(const f32x4*)(r0 + FF + c);
        ua[1] = *(const f32x4*)(r1 + c); ug[1] = *(const f32x4*)(r1 + FF + c);
        ua[2] = *(const f32x4*)(r2 + c); ug[2] = *(const f32x4*)(r2 + FF + c);
        conv_act4(ua, ug, cw, cb, c, ACT + (size_t)(MP + s) * FF + c);
        if (t >= 14) { float* d = cvs + (size_t)(b * 2 + (t - 14)) * FF2; *(f32x4*)(d + c) = ua[0]; *(f32x4*)(d + FF + c) = ug[0]; }
    }
}

#ifndef PROBE_MASK
#define PROBE_MASK 0
#endif
#define PB(bit) do { if ((PROBE_MASK) & (bit)) { if (blockIdx.x == 0 && threadIdx.x == 0) ((volatile unsigned*)(lds + 147440))[1] = (unsigned)__builtin_amdgcn_s_memrealtime(); } } while (0)
#define PE(bit) do { if ((PROBE_MASK) & (bit)) { if (blockIdx.x == 0 && threadIdx.x == 0) { volatile unsigned* pw = (volatile unsigned*)(lds + 147440); pw[0] = pw[0] + ((unsigned)__builtin_amdgcn_s_memrealtime() - pw[1]); } } } while (0)
__global__ void __launch_bounds__(512, 2) yoco_fwd(Params P) {
    extern __shared__ __attribute__((aligned(16))) unsigned char lds[];
    cg::grid_group grid = cg::this_grid();
    unsigned char* ws = P.ws;
    float* out = P.out;
    const float* ada = (const float*)(ws + WS_ADA); const float* adakv = (const float*)(ws + WS_ADAKV);
    bf16_t* H = (bf16_t*)(ws + WS_H); bf16_t* HKV = (bf16_t*)(ws + WS_HKV); bf16_t* QKV = (bf16_t*)(ws + WS_QKV); bf16_t* OB = (bf16_t*)(ws + WS_O);
    bf16_t* KVB = (bf16_t*)(ws + WS_KVB); bf16_t* ACT = (bf16_t*)(ws + WS_ACT);

    if (PROBE_MASK) { if (blockIdx.x == 0 && threadIdx.x == 0) ((volatile unsigned*)(lds + 147440))[0] = 0u; }
    PB(1);
    p0_ada(lds, P);
    __syncthreads();
    p0_weights(lds, P);
    grid.sync();
    row_pass(P.in[0], P.in[1], false, nullptr, nullptr, nullptr, ada, 0, 1, H, nullptr, nullptr);
    grid.sync();
    PE(1);

    for (int sl = 0; sl < 8; ++sl) {
        const int l = sl >> 1; const bool ffn = sl & 1;
        const float* ada_l = ada + (size_t)l * 16 * 6144;
        pg8::Gemm gres;
        if (!ffn) {
            PB(2);
            const int npass = (l == 2) ? 2 : 1;
            for (int pass = 0; pass < npass; ++pass) {
                pg8::Gemm g; EpiProj E;
                if (l == 2 && pass == 0) {
                    g = pg8::Gemm{HKV, (const bf16_t*)(ws + WS_WKV), MP, 2048, 1024};
                    E = EpiProj{KVB, 2048, Extra{out + O_BKP, out + O_BKS, 0, 1024, 512}, Extra{out + O_BVP, out + O_BVS, 1024, 1024, 512}};
                } else if (l < 2) {
                    g = pg8::Gemm{H, (const bf16_t*)(ws + WS_WQKV) + (size_t)l * 1536 * 1024, MP, 1536, 1024};
                    E = EpiProj{QKV, 1536, Extra{out + O_AKP + (size_t)l * 8 * 128 * 256, out + O_AKS + (size_t)l * 128 * 256, 1024, 256, 128},
                                Extra{out + O_AVP + (size_t)l * 8 * 128 * 256, out + O_AVS + (size_t)l * 128 * 256, 1280, 256, 128}};
                } else {
                    g = pg8::Gemm{H, (const bf16_t*)(ws + WS_WQB) + (size_t)(l - 2) * 1024 * 1024, MP, 1024, 1024};
                    E = EpiProj{QKV, 1024, Extra{nullptr, nullptr, 0, 0, 0}, Extra{nullptr, nullptr, 0, 0, 0}};
                }
                sample_gemm(SgArgs{g.A, g.Bt, g.N, g.K, 0, E.O, E.ldc, E.e0, E.e1, nullptr, nullptr, nullptr, nullptr});
                pg8::StaticOrder S; S.init(g.M, g.N, gridDim.x, blockIdx.x);
                pg8::gemm_phase<EpiProj, pg8::StaticOrder>((LAS unsigned char*)lds, g, S, E);
            }
            grid.sync();
            PE(2);
            PB(4);
            if (l < 2) {
                attn_sample<0>(lds, QKV, QKV, OB, P.in[4] + (size_t)l * 8 * 128 * 256, P.in[5] + (size_t)l * 8 * 128 * 256, P.in[16], P.in[15] + l * 16);
                attn_build_tab<0>(lds, P.in[16]);
                PB(256);
                attn_prompt<0>(lds, QKV, QKV, OB, P.in[15] + l * 16);
                PE(256);
            } else {
                attn_sample<1>(lds, QKV, KVB, OB, P.in[6], P.in[7], P.in[22] + (size_t)(l - 2) * 16 * 257, nullptr);
                attn_build_tab<1>(lds, P.in[22] + (size_t)(l - 2) * 16 * 257);
                PB(512);
                attn_prompt<1>(lds, QKV, KVB, OB, nullptr);
                PE(512);
            }
            grid.sync();
            PE(4);
            gres = pg8::Gemm{OB, l < 2 ? (const bf16_t*)(ws + WS_WOA) + (size_t)l * 1024 * 1024 : (const bf16_t*)(ws + WS_WOB) + (size_t)(l - 2) * 1024 * 1024, MP, 1024, 1024};
        } else {
            PB(32);
            {
                pg8::Gemm g{H, (const bf16_t*)(ws + WS_WUP) + (size_t)l * FF2 * 1024, MP, FF2, 1024};
                EpiUp E{ACT, (float*)(ws + WS_UH), (float*)(ws + WS_USAMP), P.in[24] + (size_t)l * 3 * FF2, P.in[25] + (size_t)l * FF2, out + O_CVP + (size_t)l * 8 * 2 * FF2};
                sample_gemm(SgArgs{g.A, g.Bt, g.N, g.K, 2, nullptr, 0, Extra{nullptr, nullptr, 0, 0, 0}, Extra{nullptr, nullptr, 0, 0, 0}, nullptr, nullptr, nullptr, E.USAMP});
                pg8::StaticOrder S; S.init(g.M, g.N, gridDim.x, blockIdx.x);
                pg8::gemm_phase<EpiUp, pg8::StaticOrder>((LAS unsigned char*)lds, g, S, E);
            }
            grid.sync();
            PE(32);
            PB(64);
            fixup_phase(P, l);
            grid.sync();
            PE(64);
            gres = pg8::Gemm{ACT, (const bf16_t*)(ws + WS_WDN) + (size_t)l * 1024 * FF, MP, 1024, FF};
        }
        PB(8);
        {
            const bool first = (sl == 0);
            EpiRes E{first ? P.in[0] : out, first ? P.in[1] : out + (size_t)MP * DM, out, ada_l + (ffn ? 5 : 2) * 1024};
            sample_gemm(SgArgs{gres.A, gres.Bt, gres.N, gres.K, 1, nullptr, 0, Extra{nullptr, nullptr, 0, 0, 0}, Extra{nullptr, nullptr, 0, 0, 0}, E.xs, out, E.gate, nullptr});
            pg8::StaticOrder S; S.init(gres.M, gres.N, gridDim.x, blockIdx.x);
            pg8::gemm_phase<EpiRes, pg8::StaticOrder>((LAS unsigned char*)lds, gres, S, E);
        }
        grid.sync();
        PE(8);
        PB(16);
        {
            const float* lg = P.in[11] + (size_t)(l * 2 + (ffn ? 1 : 0)) * DM; const float* lb = P.in[12] + (size_t)(l * 2 + (ffn ? 1 : 0)) * DM;
            if (!ffn) row_pass(out, out + (size_t)MP * DM, true, lg, lb, out, ada_l, 3, 4, H, nullptr, nullptr);
            else if (l < 3) row_pass(out, out + (size_t)MP * DM, true, lg, lb, out, ada_l + 16 * 6144, 0, 1, H, l == 1 ? adakv : nullptr, l == 1 ? HKV : nullptr);
            else row_pass(out, out + (size_t)MP * DM, true, lg, lb, out, nullptr, 0, 0, nullptr, nullptr, nullptr);
        }
        if (sl < 7) grid.sync();
        PE(16);
    }
    if (PROBE_MASK) { if (blockIdx.x == 0 && threadIdx.x == 0) { const unsigned t0 = (unsigned)__builtin_amdgcn_s_memrealtime(); const unsigned wait = ((volatile unsigned*)(lds + 147440))[0];
        while ((unsigned)__builtin_amdgcn_s_memrealtime() - t0 < wait) __builtin_amdgcn_s_sleep(8); } }
}

extern "C" void kernel_launch(void* const* d_in, const int* in_sizes, int n_in, void* d_out, int out_size, void* d_ws, size_t ws_size, hipStream_t stream) {
    static int grid = 0;
    if (grid == 0) {
        if (n_in != 27 || (size_t)out_size != O_END || ws_size < WS_END) { fprintf(stderr, "kernel_launch: unexpected shapes: n_in %d out %d (want %zu) ws %zu (need %zu)\n", n_in, out_size, (size_t)O_END, ws_size, (size_t)WS_END); grid = -1; return; }
        int dev = 0, cus = 0, per_cu = 0;
        (void)hipGetDevice(&dev);
        (void)hipDeviceGetAttribute(&cus, hipDeviceAttributeMultiprocessorCount, dev);
        if (hipFuncSetAttribute((const void*)yoco_fwd, hipFuncAttributeMaxDynamicSharedMemorySize, LDS_BYTES) != hipSuccess) { fprintf(stderr, "kernel_launch: hipFuncSetAttribute failed\n"); grid = -1; return; }
        if (hipOccupancyMaxActiveBlocksPerMultiprocessor(&per_cu, (const void*)yoco_fwd, 512, LDS_BYTES) != hipSuccess || per_cu < 1) { fprintf(stderr, "kernel_launch: occupancy query says %d\n", per_cu); per_cu = 1; }
        (void)hipGetLastError();
        grid = cus;
    }
    if (grid < 0) return;
    Params p{};
    for (int i = 0; i < 27; ++i) p.in[i] = (const float*)d_in[i];
    p.out = (float*)d_out; p.ws = (unsigned char*)d_ws;
    void* args[] = {&p};
    hipError_t e = hipLaunchCooperativeKernel((const void*)yoco_fwd, dim3(grid), dim3(512), args, LDS_BYTES, stream);
    if (e != hipSuccess) fprintf(stderr, "kernel_launch: cooperative launch failed: %s (grid %d)\n", hipGetErrorString(e), grid);
}
```
